# Optimizing an MI355X kernel written in HIP

```python
import functools
import jax
import jax.numpy as jnp
from jax import lax
import numpy as np

D_MODEL = 2048
BATCH = 2
SEQ = 16384
DEPTH = 2

CTX_LEN = 256
GRID_W = 64

GLA_HEADS = 4
GLA_DK = 128
GLA_DV = 256
GLA_GATE_RANK = 16
GLA_TAU = 16.0
GLA_CHUNK = 64
LRU_WIDTH = 1024
LRU_BLOCKS = 8
LRU_C = 8.0
CONV_W = 4
MLSTM_HEADS = 8
MLSTM_DK = 128
MLSTM_DV = 256
MLSTM_CHUNK = 64
M_INIT = -1e30
N_GROUPS = 4
EXPERTS_PER_GROUP = 8
N_EXPERTS = N_GROUPS * EXPERTS_PER_GROUP
TOP_K = 2
D_EXPERT = 512
MOE_BLOCK = 128
DN_ALPHA = (2 * DEPTH) ** 0.25
DN_BETA = (8 * DEPTH) ** -0.25
LN_EPS = 1e-5
N_EVEN = (DEPTH + 1) // 2
N_ODD = DEPTH // 2
GLA_QK = GLA_HEADS * GLA_DK
GLA_V = GLA_HEADS * GLA_DV
EVEN_SIZES = (GLA_QK, GLA_QK, GLA_V, GLA_V, GLA_GATE_RANK, GLA_GATE_RANK, LRU_WIDTH, LRU_WIDTH)
EVEN_IN = sum(EVEN_SIZES)
EVEN_MIX = GLA_V + LRU_WIDTH
ML_QK = MLSTM_HEADS * MLSTM_DK
ML_V = MLSTM_HEADS * MLSTM_DV
ODD_SIZES = (ML_QK, ML_QK, ML_V, ML_V, MLSTM_HEADS, MLSTM_HEADS, MLSTM_HEADS, MLSTM_HEADS)
ODD_IN = sum(ODD_SIZES)

kernel_name = 'hybrid_gla_rglru_mlstm_hmoe_dit'


def layer_norm(x, g, b):
    xf = x.astype(jnp.float32)
    mu = jnp.mean(xf, -1, keepdims=True)
    var = jnp.mean(jnp.square(xf - mu), -1, keepdims=True)
    return ((xf - mu) * lax.rsqrt(var + LN_EPS)).astype(x.dtype) * g + b


def head_rms_norm(h, g):
    return h * lax.rsqrt(jnp.mean(jnp.square(h), -1, keepdims=True) + LN_EPS) * g


def cond_modulation(cond, w, b):
    return (jax.nn.silu(cond) @ w + b).reshape(cond.shape[0], 6, -1)


def modulate(h, m, j):
    return h * (1 + m[:, j + 1, None]) + m[:, j, None]


def split_cols(p, sizes):
    out, off = [], 0
    for s in sizes:
        out.append(p[..., off:off + s])
        off += s
    return out


def split_heads(a, n_heads):
    B, T, _ = a.shape
    return a.reshape(B, T, n_heads, -1).transpose(0, 2, 1, 3)


def merge_heads(a):
    B, H, T, d = a.shape
    return a.transpose(0, 2, 1, 3).reshape(B, T, H * d)


def to_chunks(a, chunk):
    B, H, T = a.shape[:3]
    return jnp.moveaxis(a.reshape((B, H, T // chunk, chunk) + a.shape[3:]), 2, 0)


def from_chunks(a):
    a = jnp.moveaxis(a, 0, 2)
    return a.reshape(a.shape[:2] + (-1,) + a.shape[4:])


def centred_dwconv(x, w, b):
    left = CONV_W // 2
    right = CONV_W - 1 - left
    T = x.shape[1]
    xp = jnp.pad(x, ((0, 0), (left, right), (0, 0)))
    return b + sum(xp[:, j:j + T] * w[j] for j in range(CONV_W))


def bidir_with_prefix(scan_f, scan_b, ctx_f, lat_f, ctx_b, lat_b, init, t_axis):
    def flip(a):
        return jnp.flip(a, t_axis)
    yc_f, st_f = scan_f(*ctx_f, init)
    yl_f, _ = scan_f(*lat_f, st_f)
    yc_b, st_b = scan_b(*[flip(a) for a in ctx_b], init)
    yl_b, _ = scan_b(*[flip(a) for a in lat_b], st_b)
    return yc_f + flip(yc_b), yl_f + flip(yl_b)


def gla_chunk_scan(q, k, v, log_a, s0):
    mask = jnp.tril(jnp.ones((GLA_CHUNK, GLA_CHUNK), bool))

    def step(s, blk):
        qc, kc, vc, gc = blk
        b = jnp.cumsum(gc, axis=-2)
        b_last = b[..., -1:, :]
        q_dec = qc * jnp.exp(b)
        k_inv = kc * jnp.exp(-b)
        k_end = kc * jnp.exp(b_last - b)
        att = jnp.where(mask, jnp.einsum('bhtd,bhsd->bhts', q_dec, k_inv), 0.0)
        o = jnp.einsum('bhts,bhsv->bhtv', att, vc) + jnp.einsum('bhtd,bhdv->bhtv', q_dec, s)
        s_new = jnp.swapaxes(jnp.exp(b_last), -1, -2) * s + jnp.einsum('bhsd,bhsv->bhdv', k_end, vc)
        return s_new, o

    xs = tuple(to_chunks(a, GLA_CHUNK) for a in (q, k, v, log_a))
    s_fin, o = lax.scan(step, s0, xs)
    return from_chunks(o), s_fin


def rglru_scan(xc, h0, *, w_r, b_r, w_i, b_i, lam):
    B, T, W = xc.shape
    xb = xc.reshape(B, T, LRU_BLOCKS, W // LRU_BLOCKS)
    r = jax.nn.sigmoid(jnp.einsum('btnc,ncd->btnd', xb, w_r).reshape(B, T, W) + b_r)
    i = jax.nn.sigmoid(jnp.einsum('btnc,ncd->btnd', xb, w_i).reshape(B, T, W) + b_i)
    log_a = LRU_C * r * jax.nn.log_sigmoid(lam)
    a = jnp.exp(log_a)
    u = jnp.sqrt(-jnp.expm1(2.0 * log_a)) * (i * xc)
    u = u.at[:, 0].add(a[:, 0] * h0)

    def combine(left, right):
        a_l, u_l = left
        a_r, u_r = right
        return a_l * a_r, a_r * u_l + u_r

    _, h = lax.associative_scan(combine, (a, u), axis=1)
    return h, h[:, -1]


def mlstm_chunk_scan(q, k, v, i_pre, f_log, state):
    mask = jnp.tril(jnp.ones((MLSTM_CHUNK, MLSTM_CHUNK), bool))

    def step(carry, blk):
        cs, ns, m = carry
        qc, kc, vc, ic, fc = blk
        b = jnp.cumsum(fc, axis=-1)
        dmat = jnp.where(mask, b[..., :, None] - b[..., None, :] + ic[..., None, :], -jnp.inf)
        inter = b + m[..., None]
        m_t = jnp.maximum(inter, jnp.max(dmat, -1))
        w_intra = jnp.exp(dmat - m_t[..., None])
        w_inter = jnp.exp(inter - m_t)
        s = jnp.einsum('bhtd,bhsd->bhts', qc, kc) * w_intra
        num = jnp.einsum('bhts,bhsv->bhtv', s, vc) + w_inter[..., None] * jnp.einsum('bhtd,bhdv->bhtv', qc, cs)
        den = jnp.sum(s, -1) + w_inter * jnp.einsum('bhtd,bhd->bht', qc, ns)
        h = num / jnp.maximum(jnp.abs(den), jnp.exp(-m_t))[..., None]
        b_last = b[..., -1]
        g = b_last[..., None] - b + ic
        m_new = jnp.maximum(b_last + m, jnp.max(g, -1))
        wk = jnp.exp(g - m_new[..., None])
        decay = jnp.exp(b_last + m - m_new)
        cs_new = decay[..., None, None] * cs + jnp.einsum('bhs,bhsd,bhsv->bhdv', wk, kc, vc)
        ns_new = decay[..., None] * ns + jnp.einsum('bhs,bhsd->bhd', wk, kc)
        return (cs_new, ns_new, m_new), h

    xs = tuple(to_chunks(a, MLSTM_CHUNK) for a in (q, k, v, i_pre, f_log))
    st, h = lax.scan(step, state, xs)
    return from_chunks(h), st


def even_mixer(u_lat, u_ctx, w_in, w_a2, b_a, gla_g, conv_w, conv_b, w_r, b_r, w_i, b_i, lam, w_out, ctx_out):
    def prep(u):
        q, k, v, r, af, ab, xr, xg = split_cols((u @ w_in).astype(jnp.float32), EVEN_SIZES)
        log_af = split_heads(jax.nn.log_sigmoid(af @ w_a2[0] + b_a[0]) / GLA_TAU, GLA_HEADS)
        log_ab = split_heads(jax.nn.log_sigmoid(ab @ w_a2[1] + b_a[1]) / GLA_TAU, GLA_HEADS)
        q = split_heads(q, GLA_HEADS) * GLA_DK ** -0.5
        k = split_heads(k, GLA_HEADS)
        v = split_heads(v, GLA_HEADS)
        xc = centred_dwconv(xr, conv_w, conv_b)
        return (q, k, v, log_af), (q, k, v, log_ab), r, (xc,), xg

    cf, cb, rc, xcc, gc = prep(u_ctx)
    lf, lb, rl, xcl, gl = prep(u_lat)
    B = u_lat.shape[0]
    s0 = jnp.zeros((B, GLA_HEADS, GLA_DK, GLA_DV), jnp.float32)
    o_ctx, o_lat = bidir_with_prefix(gla_chunk_scan, gla_chunk_scan, cf, lf, cb, lb, s0, 2)
    lru_f = functools.partial(rglru_scan, w_r=w_r[0], b_r=b_r[0], w_i=w_i[0], b_i=b_i[0], lam=lam[0])
    lru_b = functools.partial(rglru_scan, w_r=w_r[1], b_r=b_r[1], w_i=w_i[1], b_i=b_i[1], lam=lam[1])
    h0 = jnp.zeros((B, LRU_WIDTH), jnp.float32)
    r_ctx, r_lat = bidir_with_prefix(lru_f, lru_b, xcc, xcl, xcc, xcl, h0, 1)

    def finish(o, r, h, g, dtype):
        o = merge_heads(head_rms_norm(o, gla_g)) * jax.nn.silu(r)
        y = h * jax.nn.gelu(g)
        return jnp.concatenate([o, y], -1).astype(dtype) @ w_out

    y_lat = finish(o_lat, rl, r_lat, gl, u_lat.dtype)
    y_ctx = finish(o_ctx, rc, r_ctx, gc, u_ctx.dtype) if ctx_out else None
    return y_lat, y_ctx


def odd_mixer(u_lat, u_ctx, w_in, b_gate, ml_g, w_out, ctx_out):
    B, S, D = u_lat.shape
    rows = S // GRID_W
    u_col = u_lat.reshape(B, rows, GRID_W, D).transpose(0, 2, 1, 3).reshape(B, S, D)

    def gate(a, j):
        return jnp.swapaxes(a, 1, 2) + b_gate[j][None, :, None]

    def prep(u):
        q, k, v, o, i_f, f_f, i_b, f_b = split_cols((u @ w_in).astype(jnp.float32), ODD_SIZES)
        q = split_heads(q, MLSTM_HEADS)
        k = split_heads(k, MLSTM_HEADS) * MLSTM_DK ** -0.5
        v = split_heads(v, MLSTM_HEADS)
        fwd = (q, k, v, gate(i_f, 0), jax.nn.log_sigmoid(gate(f_f, 1)))
        bwd = (q, k, v, gate(i_b, 2), jax.nn.log_sigmoid(gate(f_b, 3)))
        return fwd, bwd, o

    cf, cb, oc = prep(u_ctx)
    lf, lb, ol = prep(u_col)
    init = (jnp.zeros((B, MLSTM_HEADS, MLSTM_DK, MLSTM_DV), jnp.float32),
            jnp.zeros((B, MLSTM_HEADS, MLSTM_DK), jnp.float32),
            jnp.full((B, MLSTM_HEADS), M_INIT, jnp.float32))
    h_ctx, h_lat = bidir_with_prefix(mlstm_chunk_scan, mlstm_chunk_scan, cf, lf, cb, lb, init, 2)

    def finish(h, o, dtype):
        return (merge_heads(head_rms_norm(h, ml_g)) * jax.nn.sigmoid(o)).astype(dtype) @ w_out

    y_col = finish(h_lat, ol, u_lat.dtype)
    y_lat = y_col.reshape(B, GRID_W, rows, D).transpose(0, 2, 1, 3).reshape(B, S, D)
    y_ctx = finish(h_ctx, oc, u_ctx.dtype) if ctx_out else None
    return y_lat, y_ctx


def hier_moe(u, w_group, b_group, w_expert, b_expert, w_gate, w_up, w_down):
    T, D = u.shape
    uf = u.astype(jnp.float32)
    g_logits = uf @ w_group + b_group
    g_idx = jnp.argmax(g_logits, -1)
    p_g = jnp.take_along_axis(jax.nn.softmax(g_logits, -1), g_idx[:, None], 1)
    e_logits = (uf @ w_expert + b_expert).reshape(T, N_GROUPS, EXPERTS_PER_GROUP)
    e_logits = jnp.take_along_axis(e_logits, g_idx[:, None, None], 1)[:, 0]
    top_p, top_i = lax.top_k(jax.nn.softmax(e_logits, -1), TOP_K)
    gate = (p_g * top_p / jnp.sum(top_p, -1, keepdims=True)).reshape(-1)
    expert_id = (g_idx[:, None] * EXPERTS_PER_GROUP + top_i).reshape(-1).astype(jnp.int32)
    token_id = jnp.repeat(jnp.arange(T, dtype=jnp.int32), TOP_K)
    n_assign = T * TOP_K
    counts = jnp.zeros((N_EXPERTS,), jnp.int32).at[expert_id].add(1)
    padded = (counts + MOE_BLOCK - 1) // MOE_BLOCK * MOE_BLOCK
    pad_end = jnp.cumsum(padded)
    pad_start = pad_end - padded
    cnt_start = jnp.cumsum(counts) - counts
    order = jnp.argsort(expert_id)
    e_sorted = expert_id[order]
    dest = pad_start[e_sorted] + jnp.arange(n_assign, dtype=jnp.int32) - cnt_start[e_sorted]
    n_blocks = -(-(n_assign + N_EXPERTS * (MOE_BLOCK - 1)) // MOE_BLOCK)
    n_slots = n_blocks * MOE_BLOCK
    slot_tok = jnp.full((n_slots,), T, jnp.int32).at[dest].set(token_id[order])
    slot_gate = jnp.zeros((n_slots,), jnp.float32).at[dest].set(gate[order])
    block_start = jnp.arange(n_blocks, dtype=jnp.int32) * MOE_BLOCK
    block_e = jnp.minimum(jnp.searchsorted(pad_end, block_start, side='right'), N_EXPERTS - 1)
    u_pad = jnp.concatenate([u, jnp.zeros((1, D), u.dtype)], 0)

    def expert_block(args):
        tok, g, e = args
        xb = u_pad[tok]
        h = jax.nn.silu(xb @ w_gate[e]) * (xb @ w_up[e])
        return (h @ w_down[e]) * g[:, None].astype(u.dtype)

    y = lax.map(expert_block, (slot_tok.reshape(n_blocks, MOE_BLOCK), slot_gate.reshape(n_blocks, MOE_BLOCK), block_e))
    out = jnp.zeros((T + 1, D), y.dtype).at[slot_tok].add(y.reshape(n_slots, D))
    return out[:T]


def setup_inputs(seed: int = 0) -> dict:
    key = jax.random.key(seed)
    keys = list(jax.random.split(key, 40))

    def nrm(shape, std):
        return std * jax.random.normal(keys.pop(), shape, jnp.float32)

    D = D_MODEL
    bw = LRU_WIDTH // LRU_BLOCKS
    x = nrm((BATCH, SEQ, D), 1.0)
    c = nrm((BATCH, D), 1.0)
    ctx = nrm((BATCH, CTX_LEN, D), 1.0)
    c_ctx = nrm((D,), 1.0)
    w_mod = nrm((DEPTH, D, 6 * D), 0.5 * D ** -0.5)
    b_mod = nrm((DEPTH, 6 * D), 0.02)
    ln_g = 1.0 + nrm((DEPTH, 2, D), 0.02)
    ln_b = nrm((DEPTH, 2, D), 0.02)
    ev_w_in = nrm((N_EVEN, D, EVEN_IN), D ** -0.5)
    gla_w_a2 = nrm((N_EVEN, 2, GLA_GATE_RANK, GLA_QK), GLA_GATE_RANK ** -0.5)
    gla_b_a = nrm((N_EVEN, 2, GLA_QK), 0.1)
    gla_norm = 1.0 + nrm((N_EVEN, GLA_DV), 0.02)
    lru_conv_w = nrm((N_EVEN, CONV_W, LRU_WIDTH), CONV_W ** -0.5)
    lru_conv_b = nrm((N_EVEN, LRU_WIDTH), 0.02)
    lru_w_r = nrm((N_EVEN, 2, LRU_BLOCKS, bw, bw), bw ** -0.5)
    lru_b_r = nrm((N_EVEN, 2, LRU_WIDTH), 0.1)
    lru_w_i = nrm((N_EVEN, 2, LRU_BLOCKS, bw, bw), bw ** -0.5)
    lru_b_i = nrm((N_EVEN, 2, LRU_WIDTH), 0.1)
    a_pow = jax.random.uniform(keys.pop(), (N_EVEN, 2, LRU_WIDTH), jnp.float32, 0.9, 0.999) ** (1.0 / LRU_C)
    lru_lam = jnp.log(a_pow) - jnp.log1p(-a_pow)
    ev_w_out = nrm((N_EVEN, EVEN_MIX, D), DN_BETA * EVEN_MIX ** -0.5)
    od_w_in = nrm((N_ODD, D, ODD_IN), D ** -0.5)
    f_bias = jnp.linspace(3.0, 6.0, MLSTM_HEADS, dtype=jnp.float32)
    zeros_h = jnp.zeros((MLSTM_HEADS,), jnp.float32)
    mlstm_b_gate = jnp.stack([zeros_h, f_bias, zeros_h, f_bias])[None] + nrm((N_ODD, 4, MLSTM_HEADS), 0.1)
    mlstm_norm = 1.0 + nrm((N_ODD, MLSTM_DV), 0.02)
    od_w_out = nrm((N_ODD, ML_V, D), DN_BETA * ML_V ** -0.5)
    moe_w_group = nrm((DEPTH, D, N_GROUPS), D ** -0.5)
    moe_b_group = nrm((DEPTH, N_GROUPS), 0.01)
    moe_w_expert = nrm((DEPTH, D, N_EXPERTS), D ** -0.5)
    moe_b_expert = nrm((DEPTH, N_EXPERTS), 0.01)
    moe_w_gate = nrm((DEPTH, N_EXPERTS, D, D_EXPERT), D ** -0.5)
    moe_w_up = nrm((DEPTH, N_EXPERTS, D, D_EXPERT), D ** -0.5)
    moe_w_down = nrm((DEPTH, N_EXPERTS, D_EXPERT, D), DN_BETA * D_EXPERT ** -0.5)
    return {'x': x, 'c': c, 'ctx': ctx, 'c_ctx': c_ctx, 'w_mod': w_mod, 'b_mod': b_mod,
            'ln_g': ln_g, 'ln_b': ln_b, 'ev_w_in': ev_w_in, 'gla_w_a2': gla_w_a2, 'gla_b_a': gla_b_a,
            'gla_norm': gla_norm, 'lru_conv_w': lru_conv_w, 'lru_conv_b': lru_conv_b,
            'lru_w_r': lru_w_r, 'lru_b_r': lru_b_r, 'lru_w_i': lru_w_i, 'lru_b_i': lru_b_i,
            'lru_lam': lru_lam, 'ev_w_out': ev_w_out, 'od_w_in': od_w_in, 'mlstm_b_gate': mlstm_b_gate,
            'mlstm_norm': mlstm_norm, 'od_w_out': od_w_out, 'moe_w_group': moe_w_group,
            'moe_b_group': moe_b_group, 'moe_w_expert': moe_w_expert, 'moe_b_expert': moe_b_expert,
            'moe_w_gate': moe_w_gate, 'moe_w_up': moe_w_up, 'moe_w_down': moe_w_down}


def reference(x, c, ctx, c_ctx, w_mod, b_mod, ln_g, ln_b, ev_w_in, gla_w_a2, gla_b_a, gla_norm,
              lru_conv_w, lru_conv_b, lru_w_r, lru_b_r, lru_w_i, lru_b_i, lru_lam, ev_w_out,
              od_w_in, mlstm_b_gate, mlstm_norm, od_w_out, moe_w_group, moe_b_group,
              moe_w_expert, moe_b_expert, moe_w_gate, moe_w_up, moe_w_down):
    B, S, D = x.shape
    h_ctx = ctx
    for l in range(DEPTH):
        last = l == DEPTH - 1
        j = l // 2
        m_lat = cond_modulation(c, w_mod[l], b_mod[l])
        m_ctx = cond_modulation(c_ctx[None], w_mod[l], b_mod[l])
        u_lat = modulate(x, m_lat, 0)
        u_ctx = modulate(h_ctx, m_ctx, 0)
        if l % 2 == 0:
            y_lat, y_ctx = even_mixer(u_lat, u_ctx, ev_w_in[j], gla_w_a2[j], gla_b_a[j], gla_norm[j],
                                      lru_conv_w[j], lru_conv_b[j], lru_w_r[j], lru_b_r[j],
                                      lru_w_i[j], lru_b_i[j], lru_lam[j], ev_w_out[j], not last)
        else:
            y_lat, y_ctx = odd_mixer(u_lat, u_ctx, od_w_in[j], mlstm_b_gate[j], mlstm_norm[j],
                                     od_w_out[j], not last)
        x = layer_norm(DN_ALPHA * x + m_lat[:, 2, None] * y_lat, ln_g[l, 0], ln_b[l, 0])
        moe_args = (moe_w_group[l], moe_b_group[l], moe_w_expert[l], moe_b_expert[l],
                    moe_w_gate[l], moe_w_up[l], moe_w_down[l])
        if last:
            y_lat = hier_moe(modulate(x, m_lat, 3).reshape(B * S, D), *moe_args).reshape(B, S, D)
        else:
            h_ctx = layer_norm(DN_ALPHA * h_ctx + m_ctx[:, 2, None] * y_ctx, ln_g[l, 0], ln_b[l, 0])
            tokens = jnp.concatenate([modulate(x, m_lat, 3).reshape(B * S, D),
                                      modulate(h_ctx, m_ctx, 3).reshape(-1, D)], 0)
            y_all = hier_moe(tokens, *moe_args)
            y_lat = y_all[:B * S].reshape(B, S, D)
            y_ctx = y_all[B * S:].reshape(h_ctx.shape)
            h_ctx = layer_norm(DN_ALPHA * h_ctx + m_ctx[:, 5, None] * y_ctx, ln_g[l, 1], ln_b[l, 1])
        x = layer_norm(DN_ALPHA * x + m_lat[:, 5, None] * y_lat, ln_g[l, 1], ln_b[l, 1])
    return x
```

```cpp
#ifndef CPU_EMU
#include <hip/hip_runtime.h>
#include <cstdio>
#endif
#include <stdint.h>
#include <stddef.h>

#ifdef CPU_EMU_SMALL
constexpr int D = 256, SEQ = 512, CTX = 128, GRIDW = 8;
#else
constexpr int D = 2048, SEQ = 16384, CTX = 256, GRIDW = 64;
#endif
constexpr int BATCH = 2, GROWS = SEQ / GRIDW;
constexpr int TL = BATCH * SEQ, TC = BATCH * CTX, T = TL + TC;
constexpr int NCH_C = CTX / 64, NCH_L = SEQ / 64, NCH = NCH_C + NCH_L;
constexpr int NP0 = 5120, NW0 = 5376, NP1 = 6144, NW1 = 6400;
constexpr int DMIX = 2048;
constexpr int NEXP = 32, DEXP = 512;
constexpr float ALPHA = 1.41421356237f, LN_EPS = 1e-5f;
constexpr int NU_GLA = BATCH * NCH * 4, NU_LRU = BATCH * NCH * 8, NU_ML = BATCH * NCH * 8;
constexpr int NTILE_MAX = (2 * T + 255) / 256 + NEXP;
constexpr int NSLOT_MAX = NTILE_MAX * 256;
constexpr int NTHREADS = 512;
static_assert(T % 256 == 0 && TL % 256 == 0 && D % 256 == 0 && SEQ % 64 == 0 && CTX % 64 == 0, "tiling");

typedef unsigned short bf16_t;
typedef short bf16x8 __attribute__((ext_vector_type(8)));
typedef short bf16x4 __attribute__((ext_vector_type(4)));
typedef float f32x4 __attribute__((ext_vector_type(4)));
typedef unsigned u32x4 __attribute__((ext_vector_type(4)));
typedef unsigned u32x2 __attribute__((ext_vector_type(2)));

constexpr size_t AL(size_t x) { return (x + 255) & ~(size_t)255; }
constexpr size_t WS_CTL = 0, CTL_BYTES = 1u << 20;
constexpr size_t WS_WGCNT = WS_CTL + CTL_BYTES;
constexpr size_t WS_MODS = WS_WGCNT + AL(2 * 1024 * 32 * 4);
constexpr size_t WS_TOKE = WS_MODS + AL((size_t)2 * 3 * 6 * D * 4);
constexpr size_t WS_TOKG = WS_TOKE + AL((size_t)T * 2 * 4);
constexpr size_t WS_TOKSLOT = WS_TOKG + AL((size_t)T * 2 * 4);
constexpr size_t WS_SLOTTOK = WS_TOKSLOT + AL((size_t)T * 2 * 4);
constexpr size_t WS_SLOTGATE = WS_SLOTTOK + AL((size_t)NSLOT_MAX * 4);
constexpr size_t WS_TILEE = WS_SLOTGATE + AL((size_t)NSLOT_MAX * 4);
constexpr size_t WS_WIN0 = WS_TILEE + AL((size_t)(NTILE_MAX + 64) * 4);
constexpr size_t WS_WIN1 = WS_WIN0 + AL((size_t)NW0 * D * 2);
constexpr size_t WS_WOUT0 = WS_WIN1 + AL((size_t)NW1 * D * 2);
constexpr size_t WS_WOUT1 = WS_WOUT0 + AL((size_t)D * DMIX * 2);
constexpr size_t WS_WLRU = WS_WOUT1 + AL((size_t)D * DMIX * 2);
constexpr size_t WS_WR = WS_WLRU + AL((size_t)32 * 128 * 128 * 2);
constexpr size_t WS_MOEW1 = WS_WR + AL((size_t)2 * 48 * D * 2);
constexpr size_t WS_MOEW2 = WS_MOEW1 + AL((size_t)NEXP * 1024 * D * 2);
constexpr size_t WS_ACT = WS_MOEW2 + AL((size_t)NEXP * D * DEXP * 2);
constexpr size_t WS_G = WS_ACT + AL((size_t)T * DMIX * 2);
constexpr size_t WS_XC = WS_G + AL((size_t)T * 32 * 4);
constexpr size_t WS_PA = WS_XC + AL((size_t)TC * D * 4);
constexpr size_t PA_P = 0;
constexpr size_t A0 = AL((size_t)T * NP0 * 2);
constexpr size_t PA0_QD = A0;
constexpr size_t PA0_KE = PA0_QD + AL((size_t)2 * T * 512 * 2);
constexpr size_t PA0_ATT = PA0_KE + AL((size_t)NU_GLA * 2 * 128 * 64 * 2);
constexpr size_t PA0_VT = PA0_ATT + AL((size_t)NU_GLA * 2 * 64 * 64 * 2);
constexpr size_t PA0_DEC = PA0_VT + AL((size_t)NU_GLA * 256 * 64 * 2);
constexpr size_t PA0_OF = PA0_DEC + AL((size_t)NU_GLA * 2 * 128 * 4);
constexpr size_t PA0_OB = PA0_OF + AL((size_t)T * 1024 * 2);
constexpr size_t PA0_HL = PA0_OB + AL((size_t)T * 1024 * 2);
constexpr size_t PA0_ACF = PA0_HL + AL((size_t)T * 1024 * 2);
constexpr size_t PA0_ACB = PA0_ACF + AL((size_t)T * 1024 * 2);
constexpr size_t PA0_AT = PA0_ACB + AL((size_t)T * 1024 * 2);
constexpr size_t PA0_HT = PA0_AT + AL((size_t)2 * BATCH * NCH * 1024 * 4);
constexpr size_t PA0_HIN = PA0_HT + AL((size_t)2 * BATCH * NCH * 1024 * 4);
constexpr size_t PA0_END = PA0_HIN + AL((size_t)2 * BATCH * NCH * 1024 * 4);
constexpr size_t A1 = AL((size_t)T * NP1 * 2);
constexpr size_t PA1_QK = A1;
constexpr size_t PA1_KT = PA1_QK + AL((size_t)NU_ML * 64 * 64 * 4);
constexpr size_t PA1_VT = PA1_KT + AL((size_t)NU_ML * 128 * 64 * 2);
constexpr size_t PA1_GT = PA1_VT + AL((size_t)NU_ML * 256 * 64 * 2);
constexpr size_t PA1_HF = PA1_GT + AL((size_t)NU_ML * 6 * 64 * 4);
constexpr size_t PA1_HB = PA1_HF + AL((size_t)TL * 2048 * 2);
constexpr size_t PA1_END = PA1_HB + AL((size_t)TL * 2048 * 2);
constexpr size_t PA_YMIX = 0;
constexpr size_t PA_H = PA_YMIX + AL((size_t)T * D * 2);
constexpr size_t PA_Y = PA_H + AL((size_t)NSLOT_MAX * DEXP * 2);
constexpr size_t PA_MOE_END = PA_Y + AL((size_t)NSLOT_MAX * D * 2);
constexpr size_t PA_BYTES = PA0_END > PA1_END ? (PA0_END > PA_MOE_END ? PA0_END : PA_MOE_END) : (PA1_END > PA_MOE_END ? PA1_END : PA_MOE_END);
constexpr size_t WS_END = WS_PA + PA_BYTES;
#ifndef CPU_EMU_SMALL
static_assert(WS_END <= (size_t)1408000000, "workspace map exceeds the guaranteed d_ws size");
#endif

#ifdef CPU_EMU
#define LAS
#define MFMA16(a, b, c) emu_mfma16(a, b, c)
#define RFL(x) (x)
static inline float fexp(float x) { return expf(x); }
#else
#define LAS __attribute__((address_space(3)))
#define MFMA16(a, b, c) __builtin_amdgcn_mfma_f32_16x16x32_bf16(a, b, c, 0, 0, 0)
#define RFL(x) __builtin_amdgcn_readfirstlane(x)
__device__ __forceinline__ float fexp(float x) { return __expf(x); }
#endif

__device__ __forceinline__ float bf2f(bf16_t h) { union { unsigned u; float f; } c; c.u = ((unsigned)h) << 16; return c.f; }
__device__ __forceinline__ bf16_t f2bf(float f) { union { float f; unsigned u; } c; c.f = f; unsigned u = c.u; u += 0x7FFFu + ((u >> 16) & 1u); return (bf16_t)(u >> 16); }
__device__ __forceinline__ unsigned pk2(float lo, float hi) { return (unsigned)f2bf(lo) | ((unsigned)f2bf(hi) << 16); }
__device__ __forceinline__ float sigmoidf_(float x) { return 1.f / (1.f + fexp(-x)); }
__device__ __forceinline__ float siluf_(float x) { return x / (1.f + fexp(-x)); }
__device__ __forceinline__ float log_sigmoidf_(float x) { return fminf(x, 0.f) - log1pf(fexp(-fabsf(x))); }
__device__ __forceinline__ float gelu_tanhf_(float x) { const float u = 0.7978845608f * (x + 0.044715f * x * x * x); return 0.5f * x * (1.f + tanhf(u)); }
__device__ __forceinline__ float wave_sum(float v) { v += __shfl_xor(v, 32); v += __shfl_xor(v, 16); v += __shfl_xor(v, 8); v += __shfl_xor(v, 4); v += __shfl_xor(v, 2); v += __shfl_xor(v, 1); return v; }
__device__ __forceinline__ bf16x8 frag(const bf16_t* base, int ld, int row0, int k0, int lane) { return *(const bf16x8*)(base + (size_t)(row0 + (lane & 15)) * ld + k0 + ((lane >> 4) << 3)); }
__device__ __forceinline__ f32x4 fzero4() { f32x4 z = {0.f, 0.f, 0.f, 0.f}; return z; }

__device__ __forceinline__ int chunk_row0(int b, int c) { return c < NCH_C ? TL + b * CTX + 64 * c : b * SEQ + 64 * (c - NCH_C); }
__device__ __forceinline__ int scan_chunk(int dir, int i) { return dir == 0 ? i : (i < NCH_C ? NCH_C - 1 - i : NCH_C + (NCH_L - 1 - (i - NCH_C))); }
__device__ __forceinline__ int raster_of_p(int p) { const int b = p / SEQ, q = p % SEQ, w = q / GROWS, r = q % GROWS; return b * SEQ + r * GRIDW + w; }

struct Args {
    const float* in[31];
    float* out;
    unsigned char* ws;
    int ph_lo, ph_hi;
};

#ifndef CPU_EMU
#define XB_TMO      128
#define XB_XCNT(j)  (256  + 64 * (j))
#define XB_XSUB(j)  (1280 + 64 * (j))
#define XB_XGEN(j)  (2304 + 64 * (j))
#define XB_TOP      3328
#define XB_TOPGEN   3392
#define XCD_BAR_WORDS 3456
#define XB_SPIN_CAP (1u << 22)
__device__ __forceinline__ unsigned xb_ld(unsigned* p)              { return __hip_atomic_load(p, __ATOMIC_RELAXED, __HIP_MEMORY_SCOPE_AGENT); }
__device__ __forceinline__ unsigned xb_add(unsigned* p, unsigned v) { return __hip_atomic_fetch_add(p, v, __ATOMIC_RELAXED, __HIP_MEMORY_SCOPE_AGENT); }
__device__ __forceinline__ unsigned xb_xcc_id() { return (unsigned)__builtin_amdgcn_s_getreg((3 << 11) | 20) & 0xFu; }
#define XB_SPIN(cond, bar) do { unsigned _sp = 0; while (cond) { __builtin_amdgcn_s_sleep(1); \
    if ((++_sp & 255u) == 0u) { if (xb_ld(&(bar)[XB_TMO])) break; if (_sp > XB_SPIN_CAP) { atomicAdd(&(bar)[XB_TMO], 1u); break; } } } } while (0)
struct XcdBarrier { unsigned* bar; unsigned x; volatile LAS unsigned* st; };
__device__ __forceinline__ XcdBarrier xcd_barrier_post(unsigned* bar, volatile LAS unsigned* st) {
    XcdBarrier b; b.bar = bar; b.x = xb_xcc_id(); b.st = st;
    if (threadIdx.x == 0) (void)xb_add(&bar[XB_XCNT(b.x)], 1u);
    return b;
}
__device__ __forceinline__ void xcd_barrier_complete(unsigned* bar, unsigned x, unsigned& nloc, unsigned& nx) {
    const unsigned G = gridDim.x * gridDim.y * gridDim.z;
    unsigned sum, cnt, mine, sp = 0u;
    for (;;) {
        sum = 0u; cnt = 0u; mine = 0u;
#pragma unroll
        for (unsigned j = 0; j < 16; ++j) { const unsigned c = xb_ld(&bar[XB_XCNT(j)]); sum += c; cnt += (c > 0u) ? 1u : 0u; mine = (j == x) ? c : mine; }
        if (sum == G) break;
        __builtin_amdgcn_s_sleep(1);
        if ((++sp & 255u) == 0u) { if (xb_ld(&bar[XB_TMO])) break; if (sp > XB_SPIN_CAP) { atomicAdd(&bar[XB_TMO], 1u); break; } }
    }
    nloc = mine > 0u ? mine : 1u; nx = cnt > 0u ? cnt : 1u;
}
__device__ __forceinline__ void xcd_barrier(const XcdBarrier& b) {
    asm volatile("s_waitcnt vmcnt(0)" ::: "memory");
    __syncthreads();
    if (threadIdx.x == 0) {
        unsigned* bar = b.bar;
        __builtin_amdgcn_s_waitcnt(0);
        unsigned nloc = b.st[0], nx = b.st[1];
        if (nloc == 0u) { xcd_barrier_complete(bar, b.x, nloc, nx); b.st[0] = nloc; b.st[1] = nx; }
        const unsigned old = xb_add(&bar[XB_XSUB(b.x)], 1u);
        const unsigned gen = old / nloc;
        if (old + 1u == (gen + 1u) * nloc) {
            __builtin_amdgcn_fence(__ATOMIC_RELEASE, "agent");
            asm volatile("s_waitcnt vmcnt(0)" ::: "memory");
            const unsigned og = xb_add(&bar[XB_TOP], 1u);
            const unsigned tg = og / nx;
            if (og + 1u == (tg + 1u) * nx) xb_add(&bar[XB_TOPGEN], 1u);
            else XB_SPIN(xb_ld(&bar[XB_TOPGEN]) == tg, bar);
            __builtin_amdgcn_fence(__ATOMIC_ACQUIRE, "agent");
            xb_add(&bar[XB_XGEN(b.x)], 1u);
            asm volatile("s_waitcnt vmcnt(0)" ::: "memory");
        } else {
            XB_SPIN(xb_ld(&bar[XB_XGEN(b.x)]) == gen, bar);
            __builtin_amdgcn_fence(__ATOMIC_ACQUIRE, "agent");
            asm volatile("s_waitcnt vmcnt(0)" ::: "memory");
        }
    }
    __syncthreads();
}
#endif

constexpr int BM = 256, BK = 64, HALF = 128, HTB = HALF * BK * 2, STAGE_BYTES = 8 * HTB;
struct Unit { int pm, pn; };
struct Gemm { const bf16_t* A; const bf16_t* Bt; int K; const int* rowidx; };
__host__ __device__ __forceinline__ int lds_byte(int r, int c) { const int st = (r >> 4) * 2 + (c >> 5), rr = r & 15, cc = c & 31, ob = rr * 64 + cc * 2; return st * 1024 + (ob ^ (((ob >> 9) & 1) << 5)); }
__host__ __device__ __forceinline__ void stage_rc(int b, int& R, int& C) { const int st = b / 1024, sb = b % 1024, swz = sb ^ (((sb >> 9) & 1) << 5); R = (st >> 1) * 16 + swz / 64; C = (st & 1) * 32 + (swz % 64) / 2; }
__host__ __device__ __forceinline__ int perm32(int rho) { const int n = rho >> 4, i = rho & 15; return 8 * (i >> 2) + 4 * n + (i & 3); }

struct StaticOrder {
    int nM, nN, G, c;
    __device__ __forceinline__ bool next(int i, Unit& u) const { const long L = (long)i * G + c; if (L >= (long)nM * nN) return false; u.pm = (int)(L / nN); u.pn = (int)(L % nN); return true; }
};
struct MoeOrder {
    const int* tile_e; int NT, ncol, G, c;
    __device__ __forceinline__ bool next(int i, Unit& u) const { const long L = (long)i * G + c; if (L >= (long)NT * ncol) return false; const int t = (int)(L / ncol), j = (int)(L % ncol); u.pm = t; u.pn = tile_e[t] * ncol + j; return true; }
};

#ifdef CPU_EMU
template <class Epi, class Sched>
__device__ __forceinline__ void gemm_phase(unsigned char* lds, const Gemm g, const Sched& S, const Epi& E) {
    const int tid = threadIdx.x, wid = tid >> 6, lane = tid & 63, wr = wid >> 2, wc = wid & 3, fr = lane & 15, fq = lane >> 4;
    Unit u;
    for (int ui = 0; S.next(ui, u); ++ui) {
        f32x4 acc[2][2][4][2];
        for (int ai = 0; ai < 2; ++ai) for (int m = 0; m < 4; ++m) {
            const int rr = 128 * ai + 64 * wr + 16 * m + fr;
            const size_t arow = g.rowidx ? (size_t)g.rowidx[256 * u.pm + rr] : (size_t)256 * u.pm + rr;
            const bf16_t* ap = g.A + arow * g.K;
            for (int bj = 0; bj < 2; ++bj) for (int n = 0; n < 2; ++n) for (int e = 0; e < 4; ++e) {
                const int col = 256 * u.pn + 128 * bj + 32 * wc + 8 * fq + 4 * n + e;
                const bf16_t* bp = g.Bt + (size_t)col * g.K;
                float s = 0.f; for (int k = 0; k < g.K; ++k) s += bf2f(ap[k]) * bf2f(bp[k]);
                acc[ai][bj][m][n][e] = s;
            }
        }
        E(acc, u, wr, wc, fr, fq);
    }
    (void)lds;
}
#else
template <class Epi, class Sched>
__device__ __forceinline__ void gemm_phase(LAS unsigned char* lds, const Gemm g, const Sched& S, const Epi& E) {
    const int tid = threadIdx.x, wid = __builtin_amdgcn_readfirstlane(tid >> 6), lane = tid & 63, wr = wid >> 2, wc = wid & 3, fr = lane & 15, fq = lane >> 4;
    const int K = g.K, nt = K / BK;
    int Rr[2], Cc[2];
    unsigned voffB[2];
#pragma unroll
    for (int i = 0; i < 2; ++i) { stage_rc(tid * 16 + i * 8192, Rr[i], Cc[i]); const int Rb = (Rr[i] & ~31) + perm32(Rr[i] & 31); voffB[i] = (unsigned)(Rb * K + Cc[i]) * 2u; }
    const size_t kstep = (size_t)(BK * 2);
    const size_t hstep = (size_t)HALF * K * 2;
    const size_t tstep = 2 * hstep;
    const unsigned ldsw = (unsigned)wid * 1024u;
    const int aoff = lds_byte(wr * 64 + fr, fq * 8), boff = lds_byte(wc * 32 + fr, fq * 8);
#define PG8_SA(b, h) (((b) * 2 + (h)) * HTB)
#define PG8_SB(b, h) ((4 + (b) * 2 + (h)) * HTB)
#define PG8_STAGE(bufoff, gbase, voff) do { _Pragma("unroll") for (int _i = 0; _i < 2; ++_i) \
        __builtin_amdgcn_global_load_lds((const unsigned*)((const char*)(gbase) + (voff)[_i]), (LAS unsigned*)(lds + (bufoff) + ldsw + _i * 8192), 16, 0, 0); } while (0)
#define PG8_LDA(dst, b, h) do { _Pragma("unroll") for (int m = 0; m < 4; ++m) _Pragma("unroll") for (int k = 0; k < 2; ++k) dst[m][k] = *(const LAS bf16x8*)(lds + PG8_SA(b, h) + aoff + m * 2048 + k * 1024); } while (0)
#define PG8_LDB(dst, b, h) do { _Pragma("unroll") for (int n = 0; n < 2; ++n) _Pragma("unroll") for (int k = 0; k < 2; ++k) dst[n][k] = *(const LAS bf16x8*)(lds + PG8_SB(b, h) + boff + n * 2048 + k * 1024); } while (0)
#define PG8_MMA(ai, bj, At, Bt) do { __builtin_amdgcn_s_setprio(1); _Pragma("unroll") for (int m = 0; m < 4; ++m) _Pragma("unroll") for (int n = 0; n < 2; ++n) _Pragma("unroll") for (int k = 0; k < 2; ++k) \
        acc[ai][bj][m][n] = __builtin_amdgcn_mfma_f32_16x16x32_bf16(Bt[n][k], At[m][k], acc[ai][bj][m][n], 0, 0, 0); __builtin_amdgcn_s_setprio(0); } while (0)
#define PG8_WAIT_V(n) asm volatile("s_waitcnt vmcnt(" #n ")" ::: "memory")
#define PG8_WAIT_L(n) asm volatile("s_waitcnt lgkmcnt(" #n ")" ::: "memory")
#define PG8_BAR __builtin_amdgcn_s_barrier()
#define PG8_SCHED __builtin_amdgcn_sched_barrier(0)
#define PG8_AOFF(dst, unit) do { _Pragma("unroll") for (int _h = 0; _h < 2; ++_h) _Pragma("unroll") for (int _i = 0; _i < 2; ++_i) { \
        const int _rr = _h * HALF + Rr[_i]; const unsigned _row = g.rowidx ? (unsigned)g.rowidx[(unit).pm * BM + _rr] : (unsigned)((unit).pm * BM + _rr); \
        dst[_h][_i] = (_row * (unsigned)K + (unsigned)Cc[_i]) * 2u; } } while (0)
    Unit cur, nxt; int ui = 0;
    if (!S.next(0, cur)) return;
    f32x4 acc[2][2][4][2];
#pragma unroll
    for (int a = 0; a < 2; ++a)
#pragma unroll
        for (int b = 0; b < 2; ++b)
#pragma unroll
            for (int m = 0; m < 4; ++m)
#pragma unroll
                for (int n = 0; n < 2; ++n) acc[a][b][m][n] = (f32x4){0.f, 0.f, 0.f, 0.f};
    bf16x8 At[4][2], B0[2][2], B1[2][2];
    unsigned oC[2][2], oN[2][2];
    PG8_AOFF(oC, cur);
    const char* const gA = (const char*)g.A;
    const char* cB = (const char*)g.Bt + (size_t)cur.pn * tstep;
    PG8_STAGE(PG8_SB(0, 0), cB, voffB); PG8_STAGE(PG8_SA(0, 0), gA, oC[0]); PG8_STAGE(PG8_SB(0, 1), cB + hstep, voffB); PG8_STAGE(PG8_SA(0, 1), gA, oC[1]);
    if (wr == 1) PG8_BAR;
    PG8_WAIT_V(4); PG8_BAR;
    PG8_STAGE(PG8_SB(1, 0), cB + kstep, voffB); PG8_STAGE(PG8_SA(1, 0), gA + kstep, oC[0]); PG8_STAGE(PG8_SB(1, 1), cB + hstep + kstep, voffB);
    PG8_WAIT_V(6); PG8_BAR;
    for (;;) {
        const bool has_next = S.next(ui + 1, nxt);
        if (has_next) { PG8_AOFF(oN, nxt); } else {
#pragma unroll
            for (int _h = 0; _h < 2; ++_h)
#pragma unroll
                for (int _i = 0; _i < 2; ++_i) oN[_h][_i] = oC[_h][_i]; }
        const char* nB = has_next ? (const char*)g.Bt + (size_t)nxt.pn * tstep : cB;
        for (int t = 0; t < nt; t += 2) {
            const bool last = (t == nt - 2);
            const char* a1 = gA + (size_t)(t + 1) * kstep;
            const char* a2 = last ? gA : gA + (size_t)(t + 2) * kstep; const char* b2 = last ? nB : cB + (size_t)(t + 2) * kstep;
            const char* a3 = a2 + kstep; const char* b3 = b2 + kstep;
            unsigned o2[2][2];
#pragma unroll
            for (int _h = 0; _h < 2; ++_h)
#pragma unroll
                for (int _i = 0; _i < 2; ++_i) o2[_h][_i] = last ? oN[_h][_i] : oC[_h][_i];
            PG8_LDB(B0, 0, 0); PG8_SCHED; PG8_LDA(At, 0, 0); PG8_STAGE(PG8_SA(1, 1), a1, oC[1]);
            PG8_WAIT_L(8); PG8_BAR; PG8_WAIT_L(0); PG8_MMA(0, 0, At, B0); PG8_BAR; PG8_SCHED;
            PG8_LDB(B1, 0, 1); PG8_STAGE(PG8_SB(0, 0), b2, voffB);
            PG8_BAR; PG8_WAIT_L(0); PG8_MMA(0, 1, At, B1); PG8_BAR;
            PG8_LDA(At, 0, 1); PG8_STAGE(PG8_SA(0, 0), a2, o2[0]);
            PG8_BAR; PG8_WAIT_L(0); PG8_MMA(1, 0, At, B0); PG8_BAR; PG8_SCHED;
            PG8_STAGE(PG8_SB(0, 1), b2 + hstep, voffB);
            PG8_WAIT_V(6); PG8_BAR; PG8_MMA(1, 1, At, B1); PG8_BAR;
            PG8_LDB(B0, 1, 0); PG8_SCHED; PG8_LDA(At, 1, 0); PG8_STAGE(PG8_SA(0, 1), a2, o2[1]);
            PG8_WAIT_L(8); PG8_BAR; PG8_WAIT_L(0); PG8_MMA(0, 0, At, B0); PG8_BAR; PG8_SCHED;
            PG8_LDB(B1, 1, 1); PG8_STAGE(PG8_SB(1, 0), b3, voffB);
            PG8_BAR; PG8_WAIT_L(0); PG8_MMA(0, 1, At, B1); PG8_BAR;
            PG8_LDA(At, 1, 1); PG8_STAGE(PG8_SA(1, 0), a3, o2[0]);
            PG8_BAR; PG8_WAIT_L(0); PG8_MMA(1, 0, At, B0); PG8_BAR; PG8_SCHED;
            PG8_STAGE(PG8_SB(1, 1), b3 + hstep, voffB);
            PG8_WAIT_V(6); PG8_BAR; PG8_MMA(1, 1, At, B1); PG8_BAR;
        }
        E(acc, cur, wr, wc, fr, fq);
        if (!has_next) break;
#pragma unroll
        for (int a = 0; a < 2; ++a)
#pragma unroll
            for (int b = 0; b < 2; ++b)
#pragma unroll
                for (int m = 0; m < 4; ++m)
#pragma unroll
                    for (int n = 0; n < 2; ++n) acc[a][b][m][n] = (f32x4){0.f, 0.f, 0.f, 0.f};
        cur = nxt; cB = nB; ++ui;
#pragma unroll
        for (int _h = 0; _h < 2; ++_h)
#pragma unroll
            for (int _i = 0; _i < 2; ++_i) oC[_h][_i] = oN[_h][_i];
    }
    PG8_WAIT_V(0);
    if (wr == 0) PG8_BAR;
    PG8_BAR;
#undef PG8_SA
#undef PG8_SB
#undef PG8_STAGE
#undef PG8_LDA
#undef PG8_LDB
#undef PG8_MMA
#undef PG8_WAIT_V
#undef PG8_WAIT_L
#undef PG8_BAR
#undef PG8_SCHED
#undef PG8_AOFF
}
#endif

struct EpiIn {
    bf16_t* P; int ldp; float* G; int np;
    __device__ __forceinline__ void operator()(const f32x4 (&acc)[2][2][4][2], const Unit& u, int wr, int wc, int fr, int fq) const {
        const int row0 = u.pm * BM + wr * 64 + fr;
        if (u.pn < np) {
            const int col0 = u.pn * BM + wc * 32 + 8 * fq;
#pragma unroll
            for (int ai = 0; ai < 2; ++ai)
#pragma unroll
                for (int m = 0; m < 4; ++m) { bf16_t* rowp = P + (size_t)(row0 + ai * HALF + m * 16) * ldp + col0;
#pragma unroll
                    for (int bj = 0; bj < 2; ++bj) { const f32x4 v0 = acc[ai][bj][m][0], v1 = acc[ai][bj][m][1];
                        u32x4 o; o[0] = pk2(v0[0], v0[1]); o[1] = pk2(v0[2], v0[3]); o[2] = pk2(v1[0], v1[1]); o[3] = pk2(v1[2], v1[3]);
                        *(u32x4*)(rowp + bj * HALF) = o; } }
        } else if (wc == 0) {
#pragma unroll
            for (int ai = 0; ai < 2; ++ai)
#pragma unroll
                for (int m = 0; m < 4; ++m) { float* rowp = G + (size_t)(row0 + ai * HALF + m * 16) * 32 + 8 * fq;
                    *(f32x4*)(rowp) = acc[ai][0][m][0]; *(f32x4*)(rowp + 4) = acc[ai][0][m][1]; }
        }
    }
};
struct EpiBf {
    bf16_t* O; int ldc;
    __device__ __forceinline__ void operator()(const f32x4 (&acc)[2][2][4][2], const Unit& u, int wr, int wc, int fr, int fq) const {
        const int row0 = u.pm * BM + wr * 64 + fr, col0 = u.pn * BM + wc * 32 + 8 * fq;
#pragma unroll
        for (int ai = 0; ai < 2; ++ai)
#pragma unroll
            for (int m = 0; m < 4; ++m) { bf16_t* rowp = O + (size_t)(row0 + ai * HALF + m * 16) * ldc + col0;
#pragma unroll
                for (int bj = 0; bj < 2; ++bj) { const f32x4 v0 = acc[ai][bj][m][0], v1 = acc[ai][bj][m][1];
                    u32x4 o; o[0] = pk2(v0[0], v0[1]); o[1] = pk2(v0[2], v0[3]); o[2] = pk2(v1[0], v1[1]); o[3] = pk2(v1[2], v1[3]);
                    *(u32x4*)(rowp + bj * HALF) = o; } }
    }
};
struct EpiMoe1 {
    bf16_t* H;
    __device__ __forceinline__ void operator()(const f32x4 (&acc)[2][2][4][2], const Unit& u, int wr, int wc, int fr, int fq) const {
        const int row0 = u.pm * BM + wr * 64 + fr, col0 = (u.pn & 3) * 128 + wc * 32 + 8 * fq;
#pragma unroll
        for (int ai = 0; ai < 2; ++ai)
#pragma unroll
            for (int m = 0; m < 4; ++m) { bf16_t* rowp = H + (size_t)(row0 + ai * HALF + m * 16) * DEXP + col0;
                float h[8];
#pragma unroll
                for (int n = 0; n < 2; ++n)
#pragma unroll
                    for (int e = 0; e < 4; ++e) h[4 * n + e] = siluf_(acc[ai][0][m][n][e]) * acc[ai][1][m][n][e];
                u32x4 o; o[0] = pk2(h[0], h[1]); o[1] = pk2(h[2], h[3]); o[2] = pk2(h[4], h[5]); o[3] = pk2(h[6], h[7]);
                *(u32x4*)rowp = o; }
    }
};
struct EpiMoe2 {
    bf16_t* Y; const float* slot_gate; int ncol;
    __device__ __forceinline__ void operator()(const f32x4 (&acc)[2][2][4][2], const Unit& u, int wr, int wc, int fr, int fq) const {
        const int row0 = u.pm * BM + wr * 64 + fr, col0 = (u.pn % ncol) * BM + wc * 32 + 8 * fq;
#pragma unroll
        for (int ai = 0; ai < 2; ++ai)
#pragma unroll
            for (int m = 0; m < 4; ++m) { const int row = row0 + ai * HALF + m * 16; const float gt = slot_gate[row]; bf16_t* rowp = Y + (size_t)row * D + col0;
#pragma unroll
                for (int bj = 0; bj < 2; ++bj) { const f32x4 v0 = acc[ai][bj][m][0] * gt, v1 = acc[ai][bj][m][1] * gt;
                    u32x4 o; o[0] = pk2(v0[0], v0[1]); o[1] = pk2(v0[2], v0[3]); o[2] = pk2(v1[0], v1[1]); o[3] = pk2(v1[2], v1[3]);
                    *(u32x4*)(rowp + bj * HALF) = o; } }
    }
};

struct Frame {
    const float* const* in; float* out; unsigned char* ws; unsigned char* lds;
    int tid, lane, wave, G, bid;
};
#define WSP(type, off) ((type*)(F.ws + (off)))
#define PAP(type, off) ((type*)(F.ws + WS_PA + (off)))

template <class Fetch>
__device__ __forceinline__ void cvt_tile(const Frame& F, Fetch fetch, bf16_t* dst, int dst_ld, int n0, int k0, int nvalid) {
    float* tile = (float*)F.lds;
    { const int nn = F.tid & 63, kk0 = F.tid >> 6;
#pragma unroll
      for (int i = 0; i < 8; ++i) { const int kk = kk0 + 8 * i; tile[kk * 65 + nn] = fetch(k0 + kk, n0 + nn); } }
    __syncthreads();
    { const int kk = F.tid & 63, nn0 = F.tid >> 6;
#pragma unroll
      for (int i = 0; i < 8; ++i) { const int nn = nn0 + 8 * i; if (nn < nvalid) dst[(size_t)(n0 + nn) * dst_ld + k0 + kk] = f2bf(tile[kk * 65 + nn]); } }
    __syncthreads();
}

__device__ __forceinline__ void moe_weight_cvt(const Frame& F, int l) {
    const float* wg = F.in[28] + (size_t)l * NEXP * D * DEXP; const float* wu = F.in[29] + (size_t)l * NEXP * D * DEXP; const float* wd = F.in[30] + (size_t)l * NEXP * DEXP * D;
    bf16_t* W1 = WSP(bf16_t, WS_MOEW1); bf16_t* W2 = WSP(bf16_t, WS_MOEW2);
    constexpr int T1 = (1024 / 64) * (D / 64), T2 = (D / 64) * (DEXP / 64);
    const int ntile = NEXP * (T1 + T2);
    for (int t = F.bid; t < ntile; t += F.G) {
        const int e = t / (T1 + T2), r = t % (T1 + T2);
        if (r < T1) { const int nt_ = r / (D / 64), kt = r % (D / 64);
            const float* g_ = wg + (size_t)e * D * DEXP; const float* u_ = wu + (size_t)e * D * DEXP;
            cvt_tile(F, [=](int k, int n) { const int j = n >> 8, rho = n & 255; return rho < 128 ? g_[(size_t)k * DEXP + 128 * j + rho] : u_[(size_t)k * DEXP + 128 * j + rho - 128]; },
                     W1 + (size_t)e * 1024 * D, D, nt_ * 64, kt * 64, 64);
        } else { const int r2 = r - T1, nt_ = r2 / (DEXP / 64), kt = r2 % (DEXP / 64);
            const float* d_ = wd + (size_t)e * DEXP * D;
            cvt_tile(F, [=](int k, int n) { return d_[(size_t)k * D + n]; }, W2 + (size_t)e * D * DEXP, DEXP, nt_ * 64, kt * 64, 64);
        }
    }
}

__device__ __forceinline__ void phase_prologue(const Frame& F) {
    {
        float* sS = (float*)F.lds;
        float* sRed = sS + 3 * D;
        float* MODS = WSP(float, WS_MODS);
        constexpr int NJB = 6 * D / 128;
        bool have = false;
        for (int u = F.bid; u < 2 * NJB; u += F.G) {
            if (!have) { for (int i = F.tid; i < 3 * D; i += NTHREADS) { const int r = i / D, k = i % D; const float c = r < 2 ? F.in[1][r * D + k] : F.in[3][k]; sS[i] = siluf_(c); } __syncthreads(); have = true; }
            const int l = u / NJB, jb = u % NJB;
            const int cg = F.tid & 31, kg = F.tid >> 5;
            const float* W = F.in[4] + (size_t)l * D * 6 * D + jb * 128 + cg * 4;
            float a[3][4];
#pragma unroll
            for (int r = 0; r < 3; ++r)
#pragma unroll
                for (int e = 0; e < 4; ++e) a[r][e] = 0.f;
            for (int k = kg; k < D; k += 16) { const f32x4 w = *(const f32x4*)(W + (size_t)k * 6 * D);
#pragma unroll
                for (int r = 0; r < 3; ++r) { const float s = sS[r * D + k];
#pragma unroll
                    for (int e = 0; e < 4; ++e) a[r][e] += s * w[e]; } }
#pragma unroll
            for (int r = 0; r < 3; ++r)
#pragma unroll
                for (int e = 0; e < 4; ++e) sRed[(kg * 3 + r) * 128 + cg * 4 + e] = a[r][e];
            __syncthreads();
            if (F.tid < 384) { const int r = F.tid >> 7, j = F.tid & 127; float s = 0.f;
#pragma unroll
                for (int q = 0; q < 16; ++q) s += sRed[(q * 3 + r) * 128 + j];
                MODS[((size_t)l * 3 + r) * 6 * D + jb * 128 + j] = s + F.in[5][(size_t)l * 6 * D + jb * 128 + j]; }
            __syncthreads();
        }
        __syncthreads();
    }
    {
        constexpr int KT = D / 64;
        constexpr int J0 = (NW0 / 64) * KT, J1 = (NW1 / 64) * KT, J2 = (D / 64) * (DMIX / 64), J3 = J2, J4 = 32 * 4, J5 = 2 * KT;
        constexpr int JT = J0 + J1 + J2 + J3 + J4 + J5;
        for (int t = F.bid; t < JT; t += F.G) {
            int r = t;
            if (r < J0) { const int nt_ = r / KT, kt = r % KT; const float* src = F.in[8];
                cvt_tile(F, [=](int k, int n) { float v = 0.f; if (n < 3072) v = src[(size_t)k * 5152 + n]; else if (n < 5120) v = src[(size_t)k * 5152 + n + 32]; else if (n < 5152) v = src[(size_t)k * 5152 + n - 5120 + 3072];
                                                 return n < 512 ? v * 0.08838834764831845f : v; }, WSP(bf16_t, WS_WIN0), D, nt_ * 64, kt * 64, 64);
                continue; }
            r -= J0;
            if (r < J1) { const int nt_ = r / KT, kt = r % KT; const float* src = F.in[20];
                cvt_tile(F, [=](int k, int n) { float v = n < 6176 ? src[(size_t)k * 6176 + n] : 0.f; return (n >= 1024 && n < 2048) ? v * 0.08838834764831845f : v; }, WSP(bf16_t, WS_WIN1), D, nt_ * 64, kt * 64, 64);
                continue; }
            r -= J1;
            if (r < J2 + J3) { const int which = r / J2; r %= J2; const int nt_ = r / (DMIX / 64), kt = r % (DMIX / 64); const float* src = F.in[which ? 23 : 19];
                cvt_tile(F, [=](int k, int n) { return src[(size_t)k * D + n]; }, WSP(bf16_t, which ? WS_WOUT1 : WS_WOUT0), DMIX, nt_ * 64, kt * 64, 64);
                continue; }
            r -= J2 + J3;
            if (r < J4) { const int mat = r / 4, q = r % 4, nt_ = q >> 1, kt = q & 1; const int dir = mat >> 4, gate = (mat >> 3) & 1, nb = mat & 7;
                const float* src = F.in[gate ? 16 : 14] + ((size_t)dir * 8 + nb) * 128 * 128;
                cvt_tile(F, [=](int k, int n) { return src[(size_t)k * 128 + n]; }, WSP(bf16_t, WS_WLRU) + (size_t)mat * 128 * 128, 128, nt_ * 64, kt * 64, 64);
                continue; }
            r -= J4;
            { const int l = r / KT, kt = r % KT; const float* wgp = F.in[24] + (size_t)l * D * 4; const float* wep = F.in[26] + (size_t)l * D * 32;
              cvt_tile(F, [=](int k, int n) { return n < 4 ? wgp[(size_t)k * 4 + n] : (n < 36 ? wep[(size_t)k * 32 + n - 4] : 0.f); }, WSP(bf16_t, WS_WR) + (size_t)l * 48 * D, D, 0, kt * 64, 48); }
        }
    }
    moe_weight_cvt(F, 0);
}

__device__ __forceinline__ void phase_modulate0(const Frame& F) {
    const float* MODS = WSP(float, WS_MODS);
    bf16_t* U = WSP(bf16_t, WS_ACT);
    const size_t n4 = (size_t)T * D / 4;
    for (size_t i = (size_t)F.bid * NTHREADS + F.tid; i < n4; i += (size_t)F.G * NTHREADS) {
        const int row = (int)(i / (D / 4)), col = (int)(i % (D / 4)) * 4;
        const int r = row < TL ? row / SEQ : 2;
        const float* xr = row < TL ? F.in[0] + (size_t)row * D : F.in[2] + (size_t)(row - TL) * D;
        const f32x4 x = *(const f32x4*)(xr + col), sh = *(const f32x4*)(MODS + (size_t)r * 6 * D + col), sc = *(const f32x4*)(MODS + (size_t)r * 6 * D + D + col);
        u32x2 o; o[0] = pk2(x[0] * (1.f + sc[0]) + sh[0], x[1] * (1.f + sc[1]) + sh[1]); o[1] = pk2(x[2] * (1.f + sc[2]) + sh[2], x[3] * (1.f + sc[3]) + sh[3]);
        *(u32x2*)(U + (size_t)row * D + col) = o;
    }
}

__device__ __forceinline__ void gla_prep_unit(const Frame& F, int ug) {
    const int h = ug & 3, bc = ug >> 2, b = bc / NCH, c = bc % NCH, row0 = chunk_row0(b, c);
    const bf16_t* P = PAP(bf16_t, PA_P); const float* Gt = WSP(float, WS_G);
    float* sG = (float*)(F.lds + 0);
    float* sW = (float*)(F.lds + 8192);
    float* sLa = (float*)(F.lds + 24576);
    bf16_t* sV = (bf16_t*)(F.lds + 24576);
    bf16_t* sQ = (bf16_t*)(F.lds + 58368);
    bf16_t* sKi = (bf16_t*)(F.lds + 75776);
    bf16_t* sKeT = (bf16_t*)(F.lds + 93184);
    float* sBl = (float*)(F.lds + 111616);
    const int tid = F.tid, lane = F.lane, w = F.wave;
#pragma unroll
    for (int i = 0; i < 4; ++i) { const int idx = tid + NTHREADS * i, s = idx >> 5, vc = idx & 31;
        *(u32x4*)(sV + s * 264 + vc * 8) = *(const u32x4*)(P + (size_t)(row0 + s) * NP0 + 1024 + h * 256 + vc * 8); }
#pragma unroll
    for (int i = 0; i < 4; ++i) { const int idx = tid + NTHREADS * i; sG[idx] = Gt[(size_t)(row0 + (idx >> 5)) * 32 + (idx & 31)]; }
#pragma unroll
    for (int i = 0; i < 8; ++i) { const int idx = tid + NTHREADS * i, dir = idx >> 11, r = (idx >> 7) & 15, d = idx & 127; sW[idx] = F.in[9][((size_t)dir * 16 + r) * 512 + h * 128 + d]; }
    __syncthreads();
    { bf16_t* VT = PAP(bf16_t, PA0_VT) + (size_t)ug * 256 * 64;
#pragma unroll
      for (int i = 0; i < 4; ++i) { const int idx = tid + NTHREADS * i, v = idx >> 3, sc = idx & 7; bf16x8 o;
#pragma unroll
          for (int e = 0; e < 8; ++e) o[e] = (short)sV[(sc * 8 + e) * 264 + v];
          *(bf16x8*)(VT + v * 64 + sc * 8) = o; } }
    __syncthreads();
    for (int dir = 0; dir < 2; ++dir) {
        { const int d = tid & 127, tq = tid >> 7; const float bias = F.in[10][dir * 512 + h * 128 + d];
#pragma unroll 2
          for (int i = 0; i < 16; ++i) { const int t = tq * 16 + i; float z = bias;
#pragma unroll
              for (int r = 0; r < 16; ++r) z += sG[t * 32 + dir * 16 + r] * sW[(dir * 16 + r) * 128 + d];
              sLa[t * 128 + d] = log_sigmoidf_(z) * (1.f / 16.f); } }
        __syncthreads();
        if (tid < 128) { const int d = tid; float run = 0.f;
            if (dir == 0) { for (int t = 0; t < 64; ++t) { run += sLa[t * 128 + d]; sLa[t * 128 + d] = run; } }
            else { for (int t = 63; t >= 0; --t) { run += sLa[t * 128 + d]; sLa[t * 128 + d] = run; } }
            sBl[d] = run; PAP(float, PA0_DEC)[((size_t)ug * 2 + dir) * 128 + d] = fexp(run); }
        __syncthreads();
        { bf16_t* QD = PAP(bf16_t, PA0_QD) + (size_t)dir * T * 512;
#pragma unroll
          for (int i = 0; i < 2; ++i) { const int idx = tid + NTHREADS * i, t = idx >> 4, d0 = (idx & 15) * 8;
              const bf16x8 q = *(const bf16x8*)(P + (size_t)(row0 + t) * NP0 + h * 128 + d0), k = *(const bf16x8*)(P + (size_t)(row0 + t) * NP0 + 512 + h * 128 + d0);
              bf16x8 qd, ki;
#pragma unroll
              for (int e = 0; e < 8; ++e) { const float bb = sLa[t * 128 + d0 + e]; const float kf = bf2f((bf16_t)k[e]);
                  qd[e] = (short)f2bf(bf2f((bf16_t)q[e]) * fexp(bb)); ki[e] = (short)f2bf(kf * fexp(-bb)); sKeT[(d0 + e) * 72 + t] = f2bf(kf * fexp(sBl[d0 + e] - bb)); }
              *(bf16x8*)(sQ + t * 136 + d0) = qd; *(bf16x8*)(sKi + t * 136 + d0) = ki;
              *(bf16x8*)(QD + (size_t)(row0 + t) * 512 + h * 128 + d0) = qd; } }
        __syncthreads();
        { const int mt = w & 3, nt0 = (w >> 2) * 2; bf16_t* ATT = PAP(bf16_t, PA0_ATT) + ((size_t)ug * 2 + dir) * 64 * 64;
#pragma unroll
          for (int nn = 0; nn < 2; ++nn) { const int nt_ = nt0 + nn; f32x4 acc = fzero4();
#pragma unroll
              for (int ks = 0; ks < 4; ++ks) acc = MFMA16(frag(sQ, 136, 16 * mt, 32 * ks, lane), frag(sKi, 136, 16 * nt_, 32 * ks, lane), acc);
              const int s = 16 * nt_ + (lane & 15);
#pragma unroll
              for (int j = 0; j < 4; ++j) { const int t = 16 * mt + 4 * (lane >> 4) + j; const bool keep = dir == 0 ? (s <= t) : (s >= t); ATT[t * 64 + s] = f2bf(keep ? acc[j] : 0.f); } }
          bf16_t* KE = PAP(bf16_t, PA0_KE) + ((size_t)ug * 2 + dir) * 128 * 64;
#pragma unroll
          for (int i = 0; i < 2; ++i) { const int idx = tid + NTHREADS * i, d = idx >> 3, sc = idx & 7; *(u32x4*)(KE + d * 64 + sc * 8) = *(const u32x4*)(sKeT + d * 72 + sc * 8); } }
        __syncthreads();
    }
}

__device__ __forceinline__ void lru_prep_unit(const Frame& F, int ul) {
    const int nb = ul & 7, bc = ul >> 3, b = bc / NCH, c = bc % NCH, row0 = chunk_row0(b, c);
    const int pos0 = c < NCH_C ? 64 * c : 64 * (c - NCH_C), seqlen = c < NCH_C ? CTX : SEQ, rbase = c < NCH_C ? TL + b * CTX : b * SEQ;
    const bf16_t* P = PAP(bf16_t, PA_P);
    float* sX = (float*)(F.lds + 0);
    float* sA = sX;
    bf16_t* sXcb = (bf16_t*)(F.lds + 34816);
    float* sU = (float*)(F.lds + 52224);
    float* sH = (float*)(F.lds + 84992);
    const int tid = F.tid, lane = F.lane, w = F.wave;
    for (int idx = tid; idx < 67 * 16; idx += NTHREADS) { const int rr = idx >> 4, cc = idx & 15, pos = pos0 + rr - 2;
        if (pos >= 0 && pos < seqlen) { const bf16x8 v = *(const bf16x8*)(P + (size_t)(rbase + pos) * NP0 + 3072 + nb * 128 + cc * 8);
#pragma unroll
            for (int e = 0; e < 8; ++e) sX[rr * 128 + cc * 8 + e] = bf2f((bf16_t)v[e]); }
        else {
#pragma unroll
            for (int e = 0; e < 8; ++e) sX[rr * 128 + cc * 8 + e] = 0.f; } }
    __syncthreads();
    { const int ch = tid & 127, tq = tid >> 7; const float cb = F.in[13][nb * 128 + ch];
      float cw[4];
#pragma unroll
      for (int j = 0; j < 4; ++j) cw[j] = F.in[12][j * 1024 + nb * 128 + ch];
#pragma unroll 2
      for (int i = 0; i < 16; ++i) { const int t = tq * 16 + i; float xc = cb;
#pragma unroll
          for (int j = 0; j < 4; ++j) xc += sX[(t + j) * 128 + ch] * cw[j];
          sXcb[t * 136 + ch] = f2bf(xc); } }
    __syncthreads();
    for (int dir = 0; dir < 2; ++dir) {
        { f32x4 ar[4], ai_[4];
#pragma unroll
          for (int m = 0; m < 4; ++m) { ar[m] = fzero4(); ai_[m] = fzero4(); }
          const bf16_t* Wr = WSP(bf16_t, WS_WLRU) + (size_t)((dir * 2 + 0) * 8 + nb) * 128 * 128;
          const bf16_t* Wi = WSP(bf16_t, WS_WLRU) + (size_t)((dir * 2 + 1) * 8 + nb) * 128 * 128;
#pragma unroll
          for (int ks = 0; ks < 4; ++ks) { const bf16x8 br = frag(Wr, 128, 16 * w, 32 * ks, lane), bi = frag(Wi, 128, 16 * w, 32 * ks, lane);
#pragma unroll
              for (int m = 0; m < 4; ++m) { const bf16x8 a = frag(sXcb, 136, 16 * m, 32 * ks, lane); ar[m] = MFMA16(a, br, ar[m]); ai_[m] = MFMA16(a, bi, ai_[m]); } }
          const int d = 16 * w + (lane & 15), ch = nb * 128 + d;
          const float brb = F.in[15][dir * 1024 + ch], bib = F.in[17][dir * 1024 + ch], lsl = log_sigmoidf_(F.in[18][dir * 1024 + ch]);
#pragma unroll
          for (int m = 0; m < 4; ++m)
#pragma unroll
              for (int j = 0; j < 4; ++j) { const int t = 16 * m + 4 * (lane >> 4) + j;
                  const float r = sigmoidf_(ar[m][j] + brb), ig = sigmoidf_(ai_[m][j] + bib), la = 8.f * r * lsl, a = fexp(la);
                  const float u = sqrtf(-expm1f(2.f * la)) * ig * bf2f(sXcb[t * 136 + d]);
                  sA[t * 128 + d] = a; sU[t * 128 + d] = u; } }
        __syncthreads();
        if (tid < 128) { const int ch = tid; float hh = 0.f, A = 1.f;
            if (dir == 0) {
#pragma unroll 8
                for (int t = 0; t < 64; ++t) { const float a = sA[t * 128 + ch]; hh = a * hh + sU[t * 128 + ch]; A *= a; sU[t * 128 + ch] = hh; sA[t * 128 + ch] = A; } }
            else {
#pragma unroll 8
                for (int t = 63; t >= 0; --t) { const float a = sA[t * 128 + ch]; hh = a * hh + sU[t * 128 + ch]; A *= a; sU[t * 128 + ch] = hh; sA[t * 128 + ch] = A; } }
            const size_t ix = (((size_t)dir * BATCH + b) * NCH + c) * 1024 + nb * 128 + ch;
            PAP(float, PA0_AT)[ix] = A; PAP(float, PA0_HT)[ix] = hh; }
        __syncthreads();
        { bf16_t* AC = PAP(bf16_t, dir ? PA0_ACB : PA0_ACF); bf16_t* HL = PAP(bf16_t, PA0_HL);
#pragma unroll
          for (int i = 0; i < 2; ++i) { const int idx = tid + NTHREADS * i, t = idx >> 4, c0 = (idx & 15) * 8; bf16x8 oa, oh;
#pragma unroll
              for (int e = 0; e < 8; ++e) { oa[e] = (short)f2bf(sA[t * 128 + c0 + e]); if (dir == 0) sH[t * 128 + c0 + e] = sU[t * 128 + c0 + e]; else oh[e] = (short)f2bf(sH[t * 128 + c0 + e] + sU[t * 128 + c0 + e]); }
              *(bf16x8*)(AC + (size_t)(row0 + t) * 1024 + nb * 128 + c0) = oa;
              if (dir == 1) *(bf16x8*)(HL + (size_t)(row0 + t) * 1024 + nb * 128 + c0) = oh; } }
        __syncthreads();
    }
}

__device__ __forceinline__ void phase_prep0(const Frame& F) {
    for (int u = F.bid; u < NU_GLA + NU_LRU; u += F.G) { if (u < NU_GLA) gla_prep_unit(F, u); else lru_prep_unit(F, u - NU_GLA); }
}

__device__ __forceinline__ void phase_seq0(const Frame& F) {
    const int tid = F.tid, lane = F.lane, w = F.wave;
    if (tid < 16) {
        for (int id = F.bid * 16 + tid; id < 2 * BATCH * 1024; id += F.G * 16) { const int dir = id / (BATCH * 1024), b = (id / 1024) % BATCH, ch = id % 1024; float st = 0.f;
            const float* AT = PAP(float, PA0_AT); const float* HT = PAP(float, PA0_HT); float* HIN = PAP(float, PA0_HIN);
            for (int i = 0; i < NCH; ++i) { const int c = scan_chunk(dir, i); const size_t ix = (((size_t)dir * BATCH + b) * NCH + c) * 1024 + ch; HIN[ix] = st; st = AT[ix] * st + HT[ix]; } }
    }
    bf16_t* sS = (bf16_t*)F.lds;
    for (int role = F.bid; role < 256; role += F.G) {
        const int scan = role >> 4, vs = role & 15, b = scan >> 3, h = (scan >> 1) & 3, dir = scan & 1;
        __syncthreads();
        for (int i = tid; i < 16 * 136; i += NTHREADS) sS[i] = 0;
        __syncthreads();
        f32x4 accS = fzero4();
        const bf16_t* QD = PAP(bf16_t, PA0_QD) + (size_t)dir * T * 512; bf16_t* O = PAP(bf16_t, dir ? PA0_OB : PA0_OF);
        for (int i = 0; i < NCH; ++i) {
            const int c = scan_chunk(dir, i), ug = (b * NCH + c) * 4 + h, row0 = chunk_row0(b, c);
            const bf16_t* ATT = PAP(bf16_t, PA0_ATT) + ((size_t)ug * 2 + dir) * 64 * 64;
            const bf16_t* VT = PAP(bf16_t, PA0_VT) + ((size_t)ug * 256 + vs * 16) * 64;
            const bf16_t* KE = PAP(bf16_t, PA0_KE) + ((size_t)ug * 2 + dir) * 128 * 64;
            if (w < 4) { const int mt = w; f32x4 acc = fzero4();
#pragma unroll
                for (int ks = 0; ks < 2; ++ks) acc = MFMA16(frag(ATT, 64, 16 * mt, 32 * ks, lane), frag(VT, 64, 0, 32 * ks, lane), acc);
#pragma unroll
                for (int ks = 0; ks < 4; ++ks) acc = MFMA16(frag(QD + (size_t)row0 * 512 + h * 128, 512, 16 * mt, 32 * ks, lane), frag(sS, 136, 0, 32 * ks, lane), acc);
#pragma unroll
                for (int j = 0; j < 4; ++j) O[(size_t)(row0 + 16 * mt + 4 * (lane >> 4) + j) * 1024 + h * 256 + vs * 16 + (lane & 15)] = f2bf(acc[j]); }
            { const float dec = PAP(float, PA0_DEC)[((size_t)ug * 2 + dir) * 128 + 16 * w + (lane & 15)];
              accS = accS * dec;
#pragma unroll
              for (int ks = 0; ks < 2; ++ks) accS = MFMA16(frag(VT, 64, 0, 32 * ks, lane), frag(KE, 64, 16 * w, 32 * ks, lane), accS); }
            __syncthreads();
#pragma unroll
            for (int j = 0; j < 4; ++j) sS[(4 * (lane >> 4) + j) * 136 + 16 * w + (lane & 15)] = f2bf(accS[j]);
            __syncthreads();
        }
    }
}

__device__ __forceinline__ void phase_finish0(const Frame& F) {
    const bf16_t* P = PAP(bf16_t, PA_P); bf16_t* Mix = WSP(bf16_t, WS_ACT);
    const bf16_t* OF = PAP(bf16_t, PA0_OF); const bf16_t* OB = PAP(bf16_t, PA0_OB);
    const bf16_t* HL = PAP(bf16_t, PA0_HL); const bf16_t* ACF = PAP(bf16_t, PA0_ACF); const bf16_t* ACB = PAP(bf16_t, PA0_ACB); const float* HIN = PAP(float, PA0_HIN);
    const int lane = F.lane;
    for (int row = F.bid * 8 + F.wave; row < T; row += F.G * 8) {
        int b, c; if (row < TL) { b = row / SEQ; c = NCH_C + (row % SEQ) / 64; } else { b = (row - TL) / CTX; c = ((row - TL) % CTX) / 64; }
        for (int h = 0; h < 4; ++h) { const int v0 = 4 * lane; const size_t o = (size_t)row * 1024 + h * 256 + v0;
            const bf16x4 a = *(const bf16x4*)(OF + o), bq = *(const bf16x4*)(OB + o), rr = *(const bf16x4*)(P + (size_t)row * NP0 + 2048 + h * 256 + v0);
            float ov[4], ss = 0.f;
#pragma unroll
            for (int e = 0; e < 4; ++e) { ov[e] = bf2f((bf16_t)a[e]) + bf2f((bf16_t)bq[e]); ss += ov[e] * ov[e]; }
            ss = wave_sum(ss); const float rs = 1.f / sqrtf(ss * (1.f / 256.f) + LN_EPS);
            float r4[4];
#pragma unroll
            for (int e = 0; e < 4; ++e) r4[e] = ov[e] * rs * F.in[11][v0 + e] * siluf_(bf2f((bf16_t)rr[e]));
            u32x2 pk; pk[0] = pk2(r4[0], r4[1]); pk[1] = pk2(r4[2], r4[3]);
            *(u32x2*)(Mix + (size_t)row * DMIX + h * 256 + v0) = pk; }
#pragma unroll
        for (int half = 0; half < 2; ++half) { const int ch0 = half * 512 + 8 * lane; const size_t o = (size_t)row * 1024 + ch0;
            const bf16x8 hl = *(const bf16x8*)(HL + o), af = *(const bf16x8*)(ACF + o), ab = *(const bf16x8*)(ACB + o), xg = *(const bf16x8*)(P + (size_t)row * NP0 + 4096 + ch0);
            const float* hf = HIN + (((size_t)0 * BATCH + b) * NCH + c) * 1024 + ch0; const float* hb = HIN + (((size_t)1 * BATCH + b) * NCH + c) * 1024 + ch0;
            float y[8];
#pragma unroll
            for (int e = 0; e < 8; ++e) { const float hh = bf2f((bf16_t)hl[e]) + bf2f((bf16_t)af[e]) * hf[e] + bf2f((bf16_t)ab[e]) * hb[e]; y[e] = hh * gelu_tanhf_(bf2f((bf16_t)xg[e])); }
            u32x4 pk; pk[0] = pk2(y[0], y[1]); pk[1] = pk2(y[2], y[3]); pk[2] = pk2(y[4], y[5]); pk[3] = pk2(y[6], y[7]);
            *(u32x4*)(Mix + (size_t)row * DMIX + 1024 + ch0) = pk; }
    }
}

struct LnCfg { int l, which, nrows, porder, router; };
__device__ __forceinline__ void phase_ln(const Frame& F, const LnCfg cfg) {
    const int l = cfg.l, tid = F.tid, lane = F.lane, w = F.wave;
    const float* MODS = WSP(float, WS_MODS) + (size_t)l * 3 * 6 * D;
    const float* lng = F.in[6] + ((size_t)l * 2 + cfg.which) * D; const float* lnb = F.in[7] + ((size_t)l * 2 + cfg.which) * D;
    bf16_t* ACT = WSP(bf16_t, WS_ACT);
    bf16_t* sU2 = (bf16_t*)F.lds;
    float* sPart = (float*)(F.lds + 16 * (D + 8) * 2);
    float* sLog = sPart + 8 * 16 * 48;
    int* sCnt = (int*)(sLog + 16 * 48);
    if (tid < 32) sCnt[tid] = 0;
    __syncthreads();
    const int NG = cfg.nrows / 16, g0 = (int)((long)F.bid * NG / F.G), g1 = (int)((long)(F.bid + 1) * NG / F.G);
    const bf16_t* Ymix = PAP(bf16_t, PA_YMIX); const bf16_t* Y = PAP(bf16_t, PA_Y); const int* TOKSLOT = WSP(int, WS_TOKSLOT);
    const float* MODS_N = WSP(float, WS_MODS) + (size_t)3 * 6 * D;
    constexpr int NV = D / 256;
    for (int g = g0; g < g1; ++g) {
        for (int rr = 0; rr < 2; ++rr) {
            const int rl = 2 * w + rr, row = 16 * g + rl;
            int mr, xrow; const float* xin; float* xout;
            if (row < TL) { mr = row / SEQ; xrow = cfg.porder ? raster_of_p(row) : row; xin = (l == 0 && cfg.which == 0) ? F.in[0] + (size_t)xrow * D : F.out + (size_t)xrow * D; xout = F.out + (size_t)xrow * D; }
            else { mr = 2; xrow = row - TL; xin = (cfg.which == 0) ? F.in[2] + (size_t)xrow * D : WSP(float, WS_XC) + (size_t)xrow * D; xout = WSP(float, WS_XC) + (size_t)xrow * D; }
            const float* mg = MODS + (size_t)mr * 6 * D + (cfg.which ? 5 : 2) * D;
            float z[NV][4]; float s1 = 0.f;
            int sl0 = 0, sl1 = 0; if (cfg.which) { sl0 = TOKSLOT[2 * row]; sl1 = TOKSLOT[2 * row + 1]; }
#pragma unroll
            for (int i = 0; i < NV; ++i) { const int col = i * 256 + lane * 4; const f32x4 x = *(const f32x4*)(xin + col), gt = *(const f32x4*)(mg + col);
                float y[4];
                if (cfg.which == 0) { const bf16x4 yv = *(const bf16x4*)(Ymix + (size_t)row * D + col);
#pragma unroll
                    for (int e = 0; e < 4; ++e) y[e] = bf2f((bf16_t)yv[e]); }
                else { const bf16x4 ya = *(const bf16x4*)(Y + (size_t)sl0 * D + col), yb = *(const bf16x4*)(Y + (size_t)sl1 * D + col);
#pragma unroll
                    for (int e = 0; e < 4; ++e) y[e] = bf2f((bf16_t)ya[e]) + bf2f((bf16_t)yb[e]); }
#pragma unroll
                for (int e = 0; e < 4; ++e) { z[i][e] = ALPHA * x[e] + gt[e] * y[e]; s1 += z[i][e]; } }
            const float mu = wave_sum(s1) * (1.f / D);
            float s2 = 0.f;
#pragma unroll
            for (int i = 0; i < NV; ++i)
#pragma unroll
                for (int e = 0; e < 4; ++e) { const float dlt = z[i][e] - mu; s2 += dlt * dlt; }
            const float rstd = 1.f / sqrtf(wave_sum(s2) * (1.f / D) + LN_EPS);
#pragma unroll
            for (int i = 0; i < NV; ++i) { const int col = i * 256 + lane * 4; const f32x4 gg = *(const f32x4*)(lng + col), bb = *(const f32x4*)(lnb + col);
                f32x4 xo;
#pragma unroll
                for (int e = 0; e < 4; ++e) xo[e] = (z[i][e] - mu) * rstd * gg[e] + bb[e];
                *(f32x4*)(xout + col) = xo;
                if (cfg.which == 0) { const f32x4 sh = *(const f32x4*)(MODS + (size_t)mr * 6 * D + 3 * D + col), sc = *(const f32x4*)(MODS + (size_t)mr * 6 * D + 4 * D + col);
                    u32x2 pk; pk[0] = pk2(xo[0] * (1.f + sc[0]) + sh[0], xo[1] * (1.f + sc[1]) + sh[1]); pk[1] = pk2(xo[2] * (1.f + sc[2]) + sh[2], xo[3] * (1.f + sc[3]) + sh[3]);
                    *(u32x2*)(ACT + (size_t)row * D + col) = pk; *(u32x2*)(sU2 + rl * (D + 8) + col) = pk; }
                else if (l == 0) { const f32x4 sh = *(const f32x4*)(MODS_N + (size_t)mr * 6 * D + col), sc = *(const f32x4*)(MODS_N + (size_t)mr * 6 * D + D + col);
                    int urow = row; if (row < TL) { const int bq = row / SEQ, s = row % SEQ, r_ = s / GRIDW, w_ = s % GRIDW; urow = bq * SEQ + w_ * GROWS + r_; }
                    u32x2 pk; pk[0] = pk2(xo[0] * (1.f + sc[0]) + sh[0], xo[1] * (1.f + sc[1]) + sh[1]); pk[1] = pk2(xo[2] * (1.f + sc[2]) + sh[2], xo[3] * (1.f + sc[3]) + sh[3]);
                    *(u32x2*)(ACT + (size_t)urow * D + col) = pk; } }
        }
        if (cfg.router) {
            __syncthreads();
            { constexpr int KW = D / 8; f32x4 acc[3] = {fzero4(), fzero4(), fzero4()}; const bf16_t* WR = WSP(bf16_t, WS_WR) + (size_t)l * 48 * D;
#pragma unroll
              for (int ks = 0; ks < KW / 32; ++ks) { const int k0 = w * KW + 32 * ks; const bf16x8 a = frag(sU2, D + 8, 0, k0, lane);
#pragma unroll
                  for (int nt_ = 0; nt_ < 3; ++nt_) acc[nt_] = MFMA16(a, frag(WR, D, 16 * nt_, k0, lane), acc[nt_]); }
#pragma unroll
              for (int nt_ = 0; nt_ < 3; ++nt_)
#pragma unroll
                  for (int j = 0; j < 4; ++j) sPart[(w * 16 + 4 * (lane >> 4) + j) * 48 + 16 * nt_ + (lane & 15)] = acc[nt_][j]; }
            __syncthreads();
            for (int i = tid; i < 16 * 48; i += NTHREADS) { const int col = i % 48; float s = 0.f;
#pragma unroll
                for (int q = 0; q < 8; ++q) s += sPart[q * 16 * 48 + i];
                if (col < 4) s += F.in[25][l * 4 + col]; else if (col < 36) s += F.in[27][l * 32 + col - 4];
                sLog[i] = s; }
            __syncthreads();
            if (tid < 16) { const float* lg = sLog + tid * 48; const int row = 16 * g + tid;
                int gi = 0; float gm = lg[0];
#pragma unroll
                for (int q = 1; q < 4; ++q) if (lg[q] > gm) { gm = lg[q]; gi = q; }
                float gs = 0.f;
#pragma unroll
                for (int q = 0; q < 4; ++q) gs += fexp(lg[q] - gm);
                const float pg = 1.f / gs;
                const float* el = lg + 4 + gi * 8;
                int i0 = 0; float m0 = el[0];
#pragma unroll
                for (int q = 1; q < 8; ++q) if (el[q] > m0) { m0 = el[q]; i0 = q; }
                int i1 = -1; float m1 = -3.0e38f;
#pragma unroll
                for (int q = 0; q < 8; ++q) if (q != i0 && el[q] > m1) { m1 = el[q]; i1 = q; }
                const float p1 = fexp(m1 - m0);
                const float g0_ = pg / (1.f + p1), g1_ = pg * p1 / (1.f + p1);
                const int e0 = gi * 8 + i0, e1 = gi * 8 + i1;
                WSP(int, WS_TOKE)[2 * row] = e0; WSP(int, WS_TOKE)[2 * row + 1] = e1; WSP(float, WS_TOKG)[2 * row] = g0_; WSP(float, WS_TOKG)[2 * row + 1] = g1_;
                atomicAdd(&sCnt[e0], 1); atomicAdd(&sCnt[e1], 1); }
            __syncthreads();
        }
    }
    if (cfg.router) { __syncthreads(); if (tid < 32) WSP(int, WS_WGCNT)[((size_t)l * 1024 + F.bid) * 32 + tid] = sCnt[tid]; }
}

__device__ __forceinline__ void phase_slots(const Frame& F, int l, int nrows) {
    int* sTot = (int*)F.lds; int* sBefore = sTot + 32; int* sStart = sTot + 64; int* sCur = sTot + 96;
    const int tid = F.tid; const int* WGCNT = WSP(int, WS_WGCNT) + (size_t)l * 1024 * 32;
    if (tid < 32) { int tot = 0, bef = 0; for (int wg = 0; wg < F.G; ++wg) { const int c = WGCNT[wg * 32 + tid]; if (wg < F.bid) bef += c; tot += c; } sTot[tid] = tot; sBefore[tid] = bef; sCur[tid] = 0; }
    __syncthreads();
    if (tid == 0) { int start = 0, tile = 0; int* TE = WSP(int, WS_TILEE);
        for (int e = 0; e < NEXP; ++e) { sStart[e] = start; const int nte = (sTot[e] + 255) / 256; if (F.bid == 0) for (int i = 0; i < nte; ++i) TE[64 + tile + i] = e; tile += nte; start += nte * 256; }
        if (F.bid == 0) TE[0] = tile; }
    __syncthreads();
    int* SLOT_TOK = WSP(int, WS_SLOTTOK); float* SLOT_GATE = WSP(float, WS_SLOTGATE); int* TOKSLOT = WSP(int, WS_TOKSLOT);
    for (int e = F.bid; e < NEXP; e += F.G) { const int lo = sStart[e] + sTot[e], hi = sStart[e] + ((sTot[e] + 255) / 256) * 256; for (int s = lo + tid; s < hi; s += NTHREADS) { SLOT_TOK[s] = 0; SLOT_GATE[s] = 0.f; } }
    const int NG = nrows / 16, r0 = 16 * (int)((long)F.bid * NG / F.G), r1 = 16 * (int)((long)(F.bid + 1) * NG / F.G);
    const int* TOKE = WSP(int, WS_TOKE); const float* TOKG = WSP(float, WS_TOKG);
    for (int idx = tid; idx < (r1 - r0) * 2; idx += NTHREADS) { const int row = r0 + (idx >> 1), k = idx & 1; const int e = TOKE[2 * row + k]; const int pos = atomicAdd(&sCur[e], 1);
        const int slot = sStart[e] + sBefore[e] + pos; SLOT_TOK[slot] = row; SLOT_GATE[slot] = TOKG[2 * row + k]; TOKSLOT[2 * row + k] = slot; }
}

__device__ __forceinline__ void ml_prep_unit(const Frame& F, int um) {
    const int h = um & 7, bc = um >> 3, b = bc / NCH, c = bc % NCH, row0 = chunk_row0(b, c);
    const bf16_t* P = PAP(bf16_t, PA_P); const float* Gt = WSP(float, WS_G);
    bf16_t* sQ = (bf16_t*)(F.lds + 0);
    bf16_t* sK = (bf16_t*)(F.lds + 17408);
    bf16_t* sV = (bf16_t*)(F.lds + 34816);
    float* sGt = (float*)(F.lds + 68608);
    const int tid = F.tid, lane = F.lane, w = F.wave;
#pragma unroll
    for (int i = 0; i < 2; ++i) { const int idx = tid + NTHREADS * i, t = idx >> 4, d0 = (idx & 15) * 8;
        *(u32x4*)(sQ + t * 136 + d0) = *(const u32x4*)(P + (size_t)(row0 + t) * NP1 + h * 128 + d0);
        *(u32x4*)(sK + t * 136 + d0) = *(const u32x4*)(P + (size_t)(row0 + t) * NP1 + 1024 + h * 128 + d0); }
#pragma unroll
    for (int i = 0; i < 4; ++i) { const int idx = tid + NTHREADS * i, s = idx >> 5, vc = idx & 31;
        *(u32x4*)(sV + s * 264 + vc * 8) = *(const u32x4*)(P + (size_t)(row0 + s) * NP1 + 2048 + h * 256 + vc * 8); }
    if (tid < 256) { const int t = tid >> 2, q = tid & 3; sGt[tid] = Gt[(size_t)(row0 + t) * 32 + q * 8 + h] + F.in[21][q * 8 + h]; }
    __syncthreads();
    { const int mt = w & 3, nt0 = (w >> 2) * 2; float* QK = PAP(float, PA1_QK) + (size_t)um * 64 * 64;
#pragma unroll
      for (int nn = 0; nn < 2; ++nn) { const int nt_ = nt0 + nn; f32x4 acc = fzero4();
#pragma unroll
          for (int ks = 0; ks < 4; ++ks) acc = MFMA16(frag(sQ, 136, 16 * mt, 32 * ks, lane), frag(sK, 136, 16 * nt_, 32 * ks, lane), acc);
#pragma unroll
          for (int j = 0; j < 4; ++j) QK[(16 * mt + 4 * (lane >> 4) + j) * 64 + 16 * nt_ + (lane & 15)] = acc[j]; } }
    { bf16_t* KT = PAP(bf16_t, PA1_KT) + (size_t)um * 128 * 64; bf16_t* VT = PAP(bf16_t, PA1_VT) + (size_t)um * 256 * 64;
#pragma unroll
      for (int i = 0; i < 2; ++i) { const int idx = tid + NTHREADS * i, d = idx >> 3, sc = idx & 7; bf16x8 o;
#pragma unroll
          for (int e = 0; e < 8; ++e) o[e] = (short)sK[(sc * 8 + e) * 136 + d];
          *(bf16x8*)(KT + d * 64 + sc * 8) = o; }
#pragma unroll
      for (int i = 0; i < 4; ++i) { const int idx = tid + NTHREADS * i, v = idx >> 3, sc = idx & 7; bf16x8 o;
#pragma unroll
          for (int e = 0; e < 8; ++e) o[e] = (short)sV[(sc * 8 + e) * 264 + v];
          *(bf16x8*)(VT + v * 64 + sc * 8) = o; } }
    if (tid < 2) { const int dir = tid; float* GT = PAP(float, PA1_GT) + ((size_t)um * 2 + dir) * 3 * 64; float run = 0.f, pm = -3.0e38f;
        for (int q = 0; q < 64; ++q) { const int t = dir ? 63 - q : q; const float ig = sGt[t * 4 + 2 * dir], fl = log_sigmoidf_(sGt[t * 4 + 2 * dir + 1]);
            run += fl; const float a = ig - run; pm = fmaxf(pm, a); GT[t] = run; GT[64 + t] = a; GT[128 + t] = pm; } }
    __syncthreads();
}
__device__ __forceinline__ void phase_prep1(const Frame& F) { for (int u = F.bid; u < NU_ML; u += F.G) ml_prep_unit(F, u); }

__device__ __forceinline__ void phase_seq1(const Frame& F) {
    const int tid = F.tid, lane = F.lane, w = F.wave;
    bf16_t* sC = (bf16_t*)(F.lds + 0);
    bf16_t* sSm = (bf16_t*)(F.lds + 8704);
    bf16_t* sVw = (bf16_t*)(F.lds + 17920);
    float* sN = (float*)(F.lds + 22528);
    float* sWk = sN + 128; float* sDen = sWk + 64; float* sWi = sDen + 64; float* sMt = sWi + 64; float* sGa = sMt + 64; float* sGb = sGa + 64; float* sGp = sGb + 64;
    const bf16_t* P = PAP(bf16_t, PA_P);
    for (int role = F.bid; role < 256; role += F.G) {
        const int scan = role >> 3, vs = role & 7, b = scan >> 4, h = (scan >> 1) & 7, dir = scan & 1;
        __syncthreads();
        for (int i = tid; i < 32 * 136; i += NTHREADS) sC[i] = 0;
        if (tid < 128) sN[tid] = 0.f;
        __syncthreads();
        f32x4 accC[2] = {fzero4(), fzero4()};
        float mstate = -1.0e30f;
        bf16_t* HO = PAP(bf16_t, dir ? PA1_HB : PA1_HF);
        for (int i = 0; i < NCH; ++i) {
            const int c = scan_chunk(dir, i), um = (b * NCH + c) * 8 + h, row0 = chunk_row0(b, c);
            const float* GT = PAP(float, PA1_GT) + ((size_t)um * 2 + dir) * 3 * 64;
            const float* QK = PAP(float, PA1_QK) + (size_t)um * 64 * 64;
            const bf16_t* KT = PAP(bf16_t, PA1_KT) + (size_t)um * 128 * 64;
            const bf16_t* VT = PAP(bf16_t, PA1_VT) + ((size_t)um * 256 + vs * 32) * 64;
            if (tid < 64) { sGb[tid] = GT[tid]; sGa[tid] = GT[64 + tid]; sGp[tid] = GT[128 + tid]; }
            __syncthreads();
            const int tl = dir ? 0 : 63;
            const float Mlast = fmaxf(mstate, sGp[tl]);
            { const int t = tid >> 3, sc = tid & 7; const float Mt = fmaxf(mstate, sGp[t]);
              const f32x4 q0 = *(const f32x4*)(QK + t * 64 + sc * 8), q1 = *(const f32x4*)(QK + t * 64 + sc * 8 + 4);
              float rs = 0.f; float v8[8];
#pragma unroll
              for (int e = 0; e < 8; ++e) { const int s = sc * 8 + e; const bool keep = dir == 0 ? (s <= t) : (s >= t); const float qk = e < 4 ? q0[e & 3] : q1[e & 3];
                  const float val = keep ? qk * fexp(sGa[s] - Mt) : 0.f; v8[e] = val; rs += val; }
              u32x4 pk; pk[0] = pk2(v8[0], v8[1]); pk[1] = pk2(v8[2], v8[3]); pk[2] = pk2(v8[4], v8[5]); pk[3] = pk2(v8[6], v8[7]);
              *(u32x4*)(sSm + t * 72 + sc * 8) = pk;
              const bf16_t* qp = P + (size_t)(row0 + t) * NP1 + h * 128 + sc * 16; const bf16x8 qa = *(const bf16x8*)qp, qb = *(const bf16x8*)(qp + 8);
              float qn = 0.f;
#pragma unroll
              for (int e = 0; e < 8; ++e) qn += bf2f((bf16_t)qa[e]) * sN[sc * 16 + e] + bf2f((bf16_t)qb[e]) * sN[sc * 16 + 8 + e];
              rs += __shfl_xor(rs, 1); rs += __shfl_xor(rs, 2); rs += __shfl_xor(rs, 4);
              qn += __shfl_xor(qn, 1); qn += __shfl_xor(qn, 2); qn += __shfl_xor(qn, 4);
              if (sc == 0) { const float wi = fexp(mstate - Mt); sWi[t] = wi; sDen[t] = rs + wi * qn; sMt[t] = sGb[t] + Mt; } }
            if (tid < 64) sWk[tid] = fexp(sGa[tid] - Mlast);
            { const int v = tid >> 4, s0 = (tid & 15) * 4; const bf16x4 vv = *(const bf16x4*)(VT + v * 64 + s0); float o4[4];
#pragma unroll
              for (int e = 0; e < 4; ++e) o4[e] = bf2f((bf16_t)vv[e]) * fexp(sGa[s0 + e] - Mlast);
              u32x2 pk; pk[0] = pk2(o4[0], o4[1]); pk[1] = pk2(o4[2], o4[3]); *(u32x2*)(sVw + v * 72 + s0) = pk; }
            __syncthreads();
            { const int mt = w & 3, nt_ = w >> 2; f32x4 a1 = fzero4(), a2 = fzero4();
#pragma unroll
              for (int ks = 0; ks < 2; ++ks) a1 = MFMA16(frag(sSm, 72, 16 * mt, 32 * ks, lane), frag(VT, 64, 16 * nt_, 32 * ks, lane), a1);
#pragma unroll
              for (int ks = 0; ks < 4; ++ks) a2 = MFMA16(frag(P + (size_t)row0 * NP1 + h * 128, NP1, 16 * mt, 32 * ks, lane), frag(sC, 136, 16 * nt_, 32 * ks, lane), a2);
              if (c >= NCH_C) {
#pragma unroll
                  for (int j = 0; j < 4; ++j) { const int t = 16 * mt + 4 * (lane >> 4) + j; const float den = fmaxf(fabsf(sDen[t]), fexp(-sMt[t]));
                      HO[(size_t)(row0 + t) * 2048 + h * 256 + vs * 32 + 16 * nt_ + (lane & 15)] = f2bf((a1[j] + sWi[t] * a2[j]) / den); } } }
            const float decay = fexp(mstate - Mlast);
#pragma unroll
            for (int m2 = 0; m2 < 2; ++m2) { accC[m2] = accC[m2] * decay;
#pragma unroll
                for (int ks = 0; ks < 2; ++ks) accC[m2] = MFMA16(frag(sVw, 72, 16 * m2, 32 * ks, lane), frag(KT, 64, 16 * w, 32 * ks, lane), accC[m2]); }
            float nn = 0.f;
            if (tid < 128) { nn = decay * sN[tid];
#pragma unroll
                for (int q = 0; q < 8; ++q) { const bf16x8 kv = *(const bf16x8*)(KT + tid * 64 + q * 8);
#pragma unroll
                    for (int e = 0; e < 8; ++e) nn += sWk[q * 8 + e] * bf2f((bf16_t)kv[e]); } }
            const float mnew = sGb[tl] + Mlast;
            __syncthreads();
#pragma unroll
            for (int m2 = 0; m2 < 2; ++m2)
#pragma unroll
                for (int j = 0; j < 4; ++j) sC[(16 * m2 + 4 * (lane >> 4) + j) * 136 + 16 * w + (lane & 15)] = f2bf(accC[m2][j]);
            if (tid < 128) sN[tid] = nn;
            mstate = mnew;
            __syncthreads();
        }
    }
}

__device__ __forceinline__ void phase_finish1(const Frame& F) {
    const bf16_t* P = PAP(bf16_t, PA_P); bf16_t* Mix = WSP(bf16_t, WS_ACT);
    const bf16_t* HF = PAP(bf16_t, PA1_HF); const bf16_t* HB = PAP(bf16_t, PA1_HB);
    const int lane = F.lane;
    for (int row = F.bid * 8 + F.wave; row < TL; row += F.G * 8) {
        for (int h = 0; h < 8; ++h) { const int v0 = 4 * lane; const size_t o = (size_t)row * 2048 + h * 256 + v0;
            const bf16x4 a = *(const bf16x4*)(HF + o), bq = *(const bf16x4*)(HB + o), og = *(const bf16x4*)(P + (size_t)row * NP1 + 4096 + h * 256 + v0);
            float hv[4], ss = 0.f;
#pragma unroll
            for (int e = 0; e < 4; ++e) { hv[e] = bf2f((bf16_t)a[e]) + bf2f((bf16_t)bq[e]); ss += hv[e] * hv[e]; }
            ss = wave_sum(ss); const float rs = 1.f / sqrtf(ss * (1.f / 256.f) + LN_EPS);
            float r4[4];
#pragma unroll
            for (int e = 0; e < 4; ++e) r4[e] = hv[e] * rs * F.in[22][v0 + e] * sigmoidf_(bf2f((bf16_t)og[e]));
            u32x2 pk; pk[0] = pk2(r4[0], r4[1]); pk[1] = pk2(r4[2], r4[3]);
            *(u32x2*)(Mix + o) = pk; }
    }
}

constexpr int N_PHASES = 22;
constexpr int LDS_BYTES = 147456;
#ifdef CPU_EMU
#define GRID_BAR() do { } while (0)
#else
#define GRID_BAR() xcd_barrier(bar)
#endif

__global__ void __launch_bounds__(NTHREADS, 2) mk_fwd(Args args) {
#ifdef CPU_EMU
    unsigned char* lds = emu_blk->lds;
#else
    extern __shared__ __attribute__((aligned(16))) unsigned char lds_raw[];
    unsigned char* lds = (unsigned char*)lds_raw;
#endif
    Frame F; F.in = args.in; F.out = args.out; F.ws = args.ws; F.lds = lds;
    F.tid = threadIdx.x; F.lane = F.tid & 63; F.wave = RFL(F.tid >> 6); F.G = gridDim.x; F.bid = blockIdx.x;
#ifndef CPU_EMU
    LAS unsigned char* ldsl = (LAS unsigned char*)lds_raw;
    volatile LAS unsigned* bst = (volatile LAS unsigned*)(ldsl + LDS_BYTES - 16);
    if (F.tid == 0) { bst[0] = 0u; bst[1] = 0u; }
    __syncthreads();
    XcdBarrier bar = xcd_barrier_post((unsigned*)(args.ws + WS_CTL) + 1024, bst);
#endif
    const int lo = args.ph_lo, hi = args.ph_hi;
#ifdef ONLY_PH
#define IN(k) ((k) == ONLY_PH && lo <= (k) && (k) < hi)
#else
#define IN(k) (lo <= (k) && (k) < hi)
#endif
#define SEAM(k) do { if (IN(k) && IN((k) + 1)) GRID_BAR(); } while (0)
#ifdef CPU_EMU
#define GEMM_LDS lds
#else
#define GEMM_LDS ldsl
#endif
    if (IN(0)) { phase_prologue(F); } SEAM(0);
    if (IN(1)) { phase_modulate0(F); } SEAM(1);
    if (IN(2)) { Gemm g{WSP(bf16_t, WS_ACT), WSP(bf16_t, WS_WIN0), D, nullptr}; StaticOrder S{T / 256, NW0 / 256, F.G, F.bid}; EpiIn E{PAP(bf16_t, PA_P), NP0, WSP(float, WS_G), NP0 / 256};
        gemm_phase(GEMM_LDS, g, S, E); } SEAM(2);
    if (IN(3)) { phase_prep0(F); } SEAM(3);
    if (IN(4)) { phase_seq0(F); } SEAM(4);
    if (IN(5)) { phase_finish0(F); } SEAM(5);
    if (IN(6)) { Gemm g{WSP(bf16_t, WS_ACT), WSP(bf16_t, WS_WOUT0), DMIX, nullptr}; StaticOrder S{T / 256, D / 256, F.G, F.bid}; EpiBf E{PAP(bf16_t, PA_YMIX), D};
        gemm_phase(GEMM_LDS, g, S, E); } SEAM(6);
    if (IN(7)) { phase_ln(F, LnCfg{0, 0, T, 0, 1}); } SEAM(7);
    if (IN(8)) { phase_slots(F, 0, T); } SEAM(8);
    if (IN(9)) { const int* TE = WSP(int, WS_TILEE); Gemm g{WSP(bf16_t, WS_ACT), WSP(bf16_t, WS_MOEW1), D, WSP(int, WS_SLOTTOK)}; MoeOrder S{TE + 64, TE[0], 4, F.G, F.bid}; EpiMoe1 E{PAP(bf16_t, PA_H)};
        gemm_phase(GEMM_LDS, g, S, E); } SEAM(9);
    if (IN(10)) { const int* TE = WSP(int, WS_TILEE); Gemm g{PAP(bf16_t, PA_H), WSP(bf16_t, WS_MOEW2), DEXP, nullptr}; MoeOrder S{TE + 64, TE[0], D / 256, F.G, F.bid}; EpiMoe2 E{PAP(bf16_t, PA_Y), WSP(float, WS_SLOTGATE), D / 256};
        gemm_phase(GEMM_LDS, g, S, E); } SEAM(10);
    if (IN(11)) { phase_ln(F, LnCfg{0, 1, T, 0, 0}); __syncthreads(); moe_weight_cvt(F, 1); } SEAM(11);
    if (IN(12)) { Gemm g{WSP(bf16_t, WS_ACT), WSP(bf16_t, WS_WIN1), D, nullptr}; StaticOrder S{T / 256, NW1 / 256, F.G, F.bid}; EpiIn E{PAP(bf16_t, PA_P), NP1, WSP(float, WS_G), NP1 / 256};
        gemm_phase(GEMM_LDS, g, S, E); } SEAM(12);
    if (IN(13)) { phase_prep1(F); } SEAM(13);
    if (IN(14)) { phase_seq1(F); } SEAM(14);
    if (IN(15)) { phase_finish1(F); } SEAM(15);
    if (IN(16)) { Gemm g{WSP(bf16_t, WS_ACT), WSP(bf16_t, WS_WOUT1), DMIX, nullptr}; StaticOrder S{TL / 256, D / 256, F.G, F.bid}; EpiBf E{PAP(bf16_t, PA_YMIX), D};
        gemm_phase(GEMM_LDS, g, S, E); } SEAM(16);
    if (IN(17)) { phase_ln(F, LnCfg{1, 0, TL, 1, 1}); } SEAM(17);
    if (IN(18)) { phase_slots(F, 1, TL); } SEAM(18);
    if (IN(19)) { const int* TE = WSP(int, WS_TILEE); Gemm g{WSP(bf16_t, WS_ACT), WSP(bf16_t, WS_MOEW1), D, WSP(int, WS_SLOTTOK)}; MoeOrder S{TE + 64, TE[0], 4, F.G, F.bid}; EpiMoe1 E{PAP(bf16_t, PA_H)};
        gemm_phase(GEMM_LDS, g, S, E); } SEAM(19);
    if (IN(20)) { const int* TE = WSP(int, WS_TILEE); Gemm g{PAP(bf16_t, PA_H), WSP(bf16_t, WS_MOEW2), DEXP, nullptr}; MoeOrder S{TE + 64, TE[0], D / 256, F.G, F.bid}; EpiMoe2 E{PAP(bf16_t, PA_Y), WSP(float, WS_SLOTGATE), D / 256};
        gemm_phase(GEMM_LDS, g, S, E); } SEAM(20);
    if (IN(21)) { phase_ln(F, LnCfg{1, 1, TL, 1, 0}); }
#undef IN
#undef SEAM
}

#ifndef MK_N_LAUNCHES
#define MK_N_LAUNCHES N_PHASES
#endif
extern "C" void kernel_launch(void* const* d_in, const int* in_sizes, int n_in, void* d_out, int out_size, void* d_ws, size_t ws_size, hipStream_t stream) {
    (void)in_sizes; (void)out_size;
    Args a{};
    for (int i = 0; i < 31 && i < n_in; ++i) a.in[i] = (const float*)d_in[i];
    a.out = (float*)d_out; a.ws = (unsigned char*)d_ws;
#ifdef CPU_EMU
    if (ws_size < WS_END) { fprintf(stderr, "ws too small: %zu < %zu\n", ws_size, (size_t)WS_END); return; }
    int grid = 32; const char* eg = getenv("EMU_GRID"); if (eg) grid = atoi(eg);
    int p0 = 0, p1 = N_PHASES; const char* e0 = getenv("EMU_PH0"); if (e0) p0 = atoi(e0); const char* e1 = getenv("EMU_PH1"); if (e1) p1 = atoi(e1);
    for (int ph = p0; ph < p1; ++ph) { a.ph_lo = ph; a.ph_hi = ph + 1; fprintf(stderr, "[emu] phase %d\n", ph); emu_launch(mk_fwd, grid, NTHREADS, LDS_BYTES, a); }
#else
    static int grid = 0;
    if (grid == 0) {
        if (n_in != 31 || ws_size < WS_END) { fprintf(stderr, "kernel_launch: n_in %d ws %zu (need %zu)\n", n_in, ws_size, (size_t)WS_END); grid = -1; return; }
        int dev = 0, cus = 0, per_cu = 0;
        hipGetDevice(&dev); hipDeviceGetAttribute(&cus, hipDeviceAttributeMultiprocessorCount, dev);
        if (hipFuncSetAttribute((const void*)mk_fwd, hipFuncAttributeMaxDynamicSharedMemorySize, LDS_BYTES) != hipSuccess) { fprintf(stderr, "kernel_launch: hipFuncSetAttribute failed\n"); grid = -1; return; }
        if (hipOccupancyMaxActiveBlocksPerMultiprocessor(&per_cu, (const void*)mk_fwd, NTHREADS, LDS_BYTES) != hipSuccess || per_cu < 1) { fprintf(stderr, "kernel_launch: occupancy query says %d\n", per_cu); }
        (void)hipGetLastError();
        grid = cus;
    }
    if (grid < 0) return;
    hipMemsetAsync((char*)d_ws + WS_CTL, 0, CTL_BYTES, stream);
    constexpr int NL = MK_N_LAUNCHES;
    for (int li = 0; li < NL; ++li) {
        a.ph_lo = (int)((long)li * N_PHASES / NL); a.ph_hi = (int)((long)(li + 1) * N_PHASES / NL);
        hipLaunchKernelGGL(mk_fwd, dim3(grid), dim3(NTHREADS), LDS_BYTES, stream, a);
    }
#endif
}
```

```cpp
#ifndef CPU_EMU
#include <hip/hip_runtime.h>
#include <cstdio>
#endif
#include <stdint.h>
#include <stddef.h>

#ifdef CPU_EMU_SMALL
constexpr int D = 256, SEQ = 512, CTX = 256, GRIDW = 8;
#else
constexpr int D = 2048, SEQ = 16384, CTX = 256, GRIDW = 64;
#endif
constexpr int BATCH = 2, GROWS = SEQ / GRIDW;
constexpr int TL = BATCH * SEQ, TC = BATCH * CTX, T = TL + TC;
constexpr int NCH_C = CTX / 64, NCH_L = SEQ / 64, NCH = NCH_C + NCH_L;
constexpr int NP0 = 5120, NW0 = 5376, NP1 = 6144, NW1 = 6400;
constexpr int DMIX = 2048;
constexpr int NEXP = 32, DEXP = 512;
constexpr float ALPHA = 1.41421356237f, LN_EPS = 1e-5f;
constexpr int NU_GLA = BATCH * NCH * 4, NU_LRU = BATCH * NCH * 8, NU_ML = BATCH * NCH * 8;
constexpr int NTILE_MAX = (2 * T + 255) / 256 + NEXP;
constexpr int NSLOT_MAX = NTILE_MAX * 256;
constexpr int NTHREADS = 512;
static_assert(T % 256 == 0 && TL % 256 == 0 && D % 256 == 0 && SEQ % 64 == 0 && CTX % 64 == 0, "tiling");

typedef unsigned short bf16_t;
typedef short bf16x8 __attribute__((ext_vector_type(8)));
typedef short bf16x4 __attribute__((ext_vector_type(4)));
typedef float f32x4 __attribute__((ext_vector_type(4)));
typedef unsigned u32x4 __attribute__((ext_vector_type(4)));
typedef unsigned u32x2 __attribute__((ext_vector_type(2)));

constexpr size_t AL(size_t x) { return (x + 255) & ~(size_t)255; }
constexpr size_t WS_CTL = 0, CTL_BYTES = 1u << 20;
constexpr size_t WS_WGCNT = WS_CTL + CTL_BYTES;
constexpr size_t WS_MODS = WS_WGCNT + AL(2 * 1024 * 32 * 4);
constexpr size_t WS_TOKE = WS_MODS + AL((size_t)2 * 3 * 6 * D * 4);
constexpr size_t WS_TOKG = WS_TOKE + AL((size_t)T * 2 * 4);
constexpr size_t WS_TOKSLOT = WS_TOKG + AL((size_t)T * 2 * 4);
constexpr size_t WS_SLOTTOK = WS_TOKSLOT + AL((size_t)T * 2 * 4);
constexpr size_t WS_SLOTGATE = WS_SLOTTOK + AL((size_t)NSLOT_MAX * 4);
constexpr size_t WS_TILEE = WS_SLOTGATE + AL((size_t)NSLOT_MAX * 4);
constexpr size_t WS_WIN0 = WS_TILEE + AL((size_t)(NTILE_MAX + 64) * 4);
constexpr size_t WS_WIN1 = WS_WIN0 + AL((size_t)NW0 * D * 2);
constexpr size_t WS_WOUT0 = WS_WIN1 + AL((size_t)NW1 * D * 2);
constexpr size_t WS_WOUT1 = WS_WOUT0 + AL((size_t)D * DMIX * 2);
constexpr size_t WS_WLRU = WS_WOUT1 + AL((size_t)D * DMIX * 2);
constexpr size_t WS_WR = WS_WLRU + AL((size_t)32 * 128 * 128 * 2);
constexpr size_t WS_MOEW1 = WS_WR + AL((size_t)2 * 48 * D * 2);
constexpr size_t WS_MOEW2 = WS_MOEW1 + AL((size_t)NEXP * 1024 * D * 2);
constexpr size_t WS_ACT = WS_MOEW2 + AL((size_t)NEXP * D * DEXP * 2);
constexpr size_t WS_G = WS_ACT + AL((size_t)T * DMIX * 2);
constexpr size_t WS_XC = WS_G + AL((size_t)T * 32 * 4);
constexpr size_t WS_PA = WS_XC + AL((size_t)TC * D * 4);
constexpr size_t PA_P = 0;
constexpr size_t A0 = AL((size_t)T * NP0 * 2);
constexpr int GC = 4, NGC = NCH_C / GC, NGL = NCH_L / GC, NGRP = NGC + NGL;
static_assert(NCH_C % GC == 0 && NCH_L % GC == 0, "groups");
constexpr size_t PA0_QD = A0;
constexpr size_t PA0_KE = PA0_QD + AL((size_t)2 * T * 512 * 2);
constexpr size_t PA0_ATT = PA0_KE + AL((size_t)NU_GLA * 2 * 128 * 64 * 2);
constexpr size_t PA0_VT = PA0_ATT + AL((size_t)NU_GLA * 2 * 64 * 64 * 2);
constexpr size_t PA0_DEC = PA0_VT + AL((size_t)NU_GLA * 256 * 64 * 2);
constexpr size_t PA0_KVG = PA0_DEC + AL((size_t)NU_GLA * 2 * 128 * 4);
constexpr size_t PA0_DECG = PA0_KVG + AL((size_t)16 * NGRP * 32768 * 2);
constexpr size_t PA0_AT = PA0_DECG + AL((size_t)16 * NGRP * 128 * 4);
constexpr size_t PA0_HT = PA0_AT + AL((size_t)2 * BATCH * NCH * 1024 * 4);
constexpr size_t PA0_HIN = PA0_HT + AL((size_t)2 * BATCH * NCH * 1024 * 4);
constexpr size_t PA0_HL = PA0_HIN + AL((size_t)2 * BATCH * NCH * 1024 * 4);
constexpr size_t PA0_ACF = PA0_HL + AL((size_t)T * 1024 * 2);
constexpr size_t PA0_ACB = PA0_ACF + AL((size_t)T * 1024 * 2);
constexpr size_t PA0_END = PA0_ACB + AL((size_t)T * 1024 * 2);
constexpr size_t A1 = AL((size_t)T * NP1 * 2);
constexpr int MLV = 272;
constexpr size_t PA1_SM = A1;
constexpr size_t PA1_KEW = PA1_SM + AL((size_t)NU_ML * 2 * 64 * 64 * 2);
constexpr size_t PA1_VT = PA1_KEW + AL((size_t)NU_ML * 2 * 128 * 64 * 2);
constexpr size_t PA1_WF = PA1_VT + AL((size_t)NU_ML * MLV * 64 * 2);
constexpr size_t PA1_DEC = PA1_WF + AL((size_t)NU_ML * 4 * 64 * 4);
constexpr size_t PA1_KVG = PA1_DEC + AL((size_t)NU_ML * 2 * 4);
constexpr size_t PA1_DG = PA1_KVG + AL((size_t)32 * NGRP * MLV * 128 * 2);
constexpr size_t PA1_END = PA1_DG + AL((size_t)32 * NGRP * 4);
constexpr size_t PA_YMIX = 0;
constexpr size_t PA_H = PA_YMIX + AL((size_t)T * D * 2);
constexpr size_t PA_Y = PA_H + AL((size_t)NSLOT_MAX * DEXP * 2);
constexpr size_t PA_XB = PA_Y + AL((size_t)NSLOT_MAX * D * 2);
constexpr size_t PA_MOE_END = PA_XB + AL((size_t)T * D * 2);
constexpr size_t PA_BYTES = PA0_END > PA1_END ? (PA0_END > PA_MOE_END ? PA0_END : PA_MOE_END) : (PA1_END > PA_MOE_END ? PA1_END : PA_MOE_END);
constexpr size_t WS_END = WS_PA + PA_BYTES;
#ifndef CPU_EMU_SMALL
static_assert(WS_END <= (size_t)1408000000, "workspace map exceeds the guaranteed d_ws size");
#endif

#ifdef CPU_EMU
#define LAS
#define MFMA16(a, b, c) emu_mfma16(a, b, c)
#define RFL(x) (x)
static inline float fexp(float x) { return expf(x); }
#else
#define LAS __attribute__((address_space(3)))
#define MFMA16(a, b, c) __builtin_amdgcn_mfma_f32_16x16x32_bf16(a, b, c, 0, 0, 0)
#define RFL(x) __builtin_amdgcn_readfirstlane(x)
__device__ __forceinline__ float fexp(float x) { return __expf(x); }
#endif

__device__ __forceinline__ float bf2f(bf16_t h) { union { unsigned u; float f; } c; c.u = ((unsigned)h) << 16; return c.f; }
__device__ __forceinline__ bf16_t f2bf(float f) { union { float f; unsigned u; } c; c.f = f; unsigned u = c.u; u += 0x7FFFu + ((u >> 16) & 1u); return (bf16_t)(u >> 16); }
#ifdef CPU_EMU
__device__ __forceinline__ unsigned pk2(float lo, float hi) { return (unsigned)f2bf(lo) | ((unsigned)f2bf(hi) << 16); }
#else
__device__ __forceinline__ unsigned pk2(float lo, float hi) { unsigned r; asm("v_cvt_pk_bf16_f32 %0, %1, %2" : "=v"(r) : "v"(lo), "v"(hi)); return r; }
#endif
__device__ __forceinline__ float sigmoidf_(float x) { return 1.f / (1.f + fexp(-x)); }
__device__ __forceinline__ float siluf_(float x) { return x / (1.f + fexp(-x)); }
__device__ __forceinline__ float log_sigmoidf_(float x) { return fminf(x, 0.f) - log1pf(fexp(-fabsf(x))); }
__device__ __forceinline__ float gelu_tanhf_(float x) { const float u = 0.7978845608f * (x + 0.044715f * x * x * x); return 0.5f * x * (1.f + tanhf(u)); }
__device__ __forceinline__ float wave_sum(float v) { v += __shfl_xor(v, 32); v += __shfl_xor(v, 16); v += __shfl_xor(v, 8); v += __shfl_xor(v, 4); v += __shfl_xor(v, 2); v += __shfl_xor(v, 1); return v; }
__device__ __forceinline__ bf16x8 frag(const bf16_t* base, int ld, int row0, int k0, int lane) { return *(const bf16x8*)(base + (size_t)(row0 + (lane & 15)) * ld + k0 + ((lane >> 4) << 3)); }
__device__ __forceinline__ bf16x8 frag_l(const bf16_t* base, int ld, int row0, int k0, int lane) { return *(const LAS bf16x8*)((const LAS bf16_t*)base + (row0 + (lane & 15)) * ld + k0 + ((lane >> 4) << 3)); }
#ifdef CPU_EMU
#define SCHED_BAR() do { } while (0)
#define OPAQUE(x) do { } while (0)
#else
#define SCHED_BAR() __builtin_amdgcn_sched_barrier(0)
#define OPAQUE(x) asm volatile("" : "+v"(x))
#endif
#ifdef CPU_EMU
#define MFMA_DRAIN() do { } while (0)
#else
#define MFMA_DRAIN() do { __builtin_amdgcn_sched_barrier(0); asm volatile("s_nop 15\n\ts_nop 15" ::: "memory"); __builtin_amdgcn_sched_barrier(0); } while (0)
#endif
__device__ __forceinline__ f32x4 fzero4() { f32x4 z = {0.f, 0.f, 0.f, 0.f}; return z; }

__device__ __forceinline__ int chunk_row0(int b, int c) { return c < NCH_C ? TL + b * CTX + 64 * c : b * SEQ + 64 * (c - NCH_C); }
__device__ __forceinline__ int scan_chunk(int dir, int i) { return dir == 0 ? i : (i < NCH_C ? NCH_C - 1 - i : NCH_C + (NCH_L - 1 - (i - NCH_C))); }
__device__ __forceinline__ int scan_group(int dir, int i) { return dir == 0 ? i : (i < NGC ? NGC - 1 - i : NGC + (NGL - 1 - (i - NGC))); }
__device__ __forceinline__ int group_chunk(int g, int dir, int j) { return g * GC + (dir ? GC - 1 - j : j); }
__device__ __forceinline__ int raster_of_p(int p) { const int b = p / SEQ, q = p % SEQ, w = q / GROWS, r = q % GROWS; return b * SEQ + r * GRIDW + w; }

struct Args {
    const float* in[31];
    float* out;
    unsigned char* ws;
    int ph_lo, ph_hi;
};

#ifndef CPU_EMU
#define XB_TMO      128
#define XB_XCNT(j)  (256  + 64 * (j))
#define XB_XSUB(j)  (1280 + 64 * (j))
#define XB_XGEN(j)  (2304 + 64 * (j))
#define XB_TOP      3328
#define XB_TOPGEN   3392
#define XCD_BAR_WORDS 3456
#define XB_SPIN_CAP (1u << 22)
__device__ __forceinline__ unsigned xb_ld(unsigned* p)              { return __hip_atomic_load(p, __ATOMIC_RELAXED, __HIP_MEMORY_SCOPE_AGENT); }
__device__ __forceinline__ unsigned xb_add(unsigned* p, unsigned v) { return __hip_atomic_fetch_add(p, v, __ATOMIC_RELAXED, __HIP_MEMORY_SCOPE_AGENT); }
__device__ __forceinline__ unsigned xb_xcc_id() { return (unsigned)__builtin_amdgcn_s_getreg((3 << 11) | 20) & 0xFu; }
#define XB_SPIN(cond, bar) do { unsigned _sp = 0; while (cond) { __builtin_amdgcn_s_sleep(1); \
    if ((++_sp & 255u) == 0u) { if (xb_ld(&(bar)[XB_TMO])) break; if (_sp > XB_SPIN_CAP) { atomicAdd(&(bar)[XB_TMO], 1u); break; } } } } while (0)
struct XcdBarrier { unsigned* bar; unsigned x; volatile LAS unsigned* st; };
__device__ __forceinline__ XcdBarrier xcd_barrier_post(unsigned* bar, volatile LAS unsigned* st) {
    XcdBarrier b; b.bar = bar; b.x = xb_xcc_id(); b.st = st;
    if (threadIdx.x == 0) (void)xb_add(&bar[XB_XCNT(b.x)], 1u);
    return b;
}
__device__ __forceinline__ void xcd_barrier_complete(unsigned* bar, unsigned x, unsigned& nloc, unsigned& nx) {
    const unsigned G = gridDim.x * gridDim.y * gridDim.z;
    unsigned sum, cnt, mine, sp = 0u;
    for (;;) {
        sum = 0u; cnt = 0u; mine = 0u;
#pragma unroll
        for (unsigned j = 0; j < 16; ++j) { const unsigned c = xb_ld(&bar[XB_XCNT(j)]); sum += c; cnt += (c > 0u) ? 1u : 0u; mine = (j == x) ? c : mine; }
        if (sum == G) break;
        __builtin_amdgcn_s_sleep(1);
        if ((++sp & 255u) == 0u) { if (xb_ld(&bar[XB_TMO])) break; if (sp > XB_SPIN_CAP) { atomicAdd(&bar[XB_TMO], 1u); break; } }
    }
    nloc = mine > 0u ? mine : 1u; nx = cnt > 0u ? cnt : 1u;
}
__device__ __forceinline__ void xcd_barrier(const XcdBarrier& b) {
    asm volatile("s_waitcnt vmcnt(0)" ::: "memory");
    __syncthreads();
    if (threadIdx.x == 0) {
        unsigned* bar = b.bar;
        __builtin_amdgcn_s_waitcnt(0);
        unsigned nloc = b.st[0], nx = b.st[1];
        if (nloc == 0u) { xcd_barrier_complete(bar, b.x, nloc, nx); b.st[0] = nloc; b.st[1] = nx; }
        const unsigned old = xb_add(&bar[XB_XSUB(b.x)], 1u);
        const unsigned gen = old / nloc;
        if (old + 1u == (gen + 1u) * nloc) {
            __builtin_amdgcn_fence(__ATOMIC_RELEASE, "agent");
            asm volatile("s_waitcnt vmcnt(0)" ::: "memory");
            const unsigned og = xb_add(&bar[XB_TOP], 1u);
            const unsigned tg = og / nx;
            if (og + 1u == (tg + 1u) * nx) xb_add(&bar[XB_TOPGEN], 1u);
            else XB_SPIN(xb_ld(&bar[XB_TOPGEN]) == tg, bar);
            __builtin_amdgcn_fence(__ATOMIC_ACQUIRE, "agent");
            xb_add(&bar[XB_XGEN(b.x)], 1u);
            asm volatile("s_waitcnt vmcnt(0)" ::: "memory");
        } else {
            XB_SPIN(xb_ld(&bar[XB_XGEN(b.x)]) == gen, bar);
            __builtin_amdgcn_fence(__ATOMIC_ACQUIRE, "agent");
            asm volatile("s_waitcnt vmcnt(0)" ::: "memory");
        }
    }
    __syncthreads();
}
#endif

constexpr int BM = 256, BK = 64, HALF = 128, HTB = HALF * BK * 2, STAGE_BYTES = 8 * HTB;
struct Unit { int pm, pn; };
struct Gemm { const bf16_t* A; const bf16_t* Bt; int K; const int* rowidx; };
__host__ __device__ __forceinline__ int lds_byte(int r, int c) { const int st = (r >> 4) * 2 + (c >> 5), rr = r & 15, cc = c & 31, ob = rr * 64 + cc * 2; return st * 1024 + (ob ^ (((ob >> 9) & 1) << 5)); }
__host__ __device__ __forceinline__ void stage_rc(int b, int& R, int& C) { const int st = b / 1024, sb = b % 1024, swz = sb ^ (((sb >> 9) & 1) << 5); R = (st >> 1) * 16 + swz / 64; C = (st & 1) * 32 + (swz % 64) / 2; }
__host__ __device__ __forceinline__ int perm32(int rho) { const int n = rho >> 4, i = rho & 15; return 8 * (i >> 2) + 4 * n + (i & 3); }

struct StaticOrder {
    int nM, nN, G, c;
    __device__ __forceinline__ bool next(int i, Unit& u) const {
        const int nU = nM * nN; long Q;
        if ((G & 7) == 0) { const int x = c & 7, l = c >> 3, W = G >> 3; const long s0 = (long)nU * x / 8, s1 = (long)nU * (x + 1) / 8; Q = s0 + (long)i * W + l; if (Q >= s1) return false; }
        else { Q = (long)i * G + c; if (Q >= nU) return false; }
        const int per = 4 * nN, gi = (int)(Q / per), rem = (int)(Q % per), rows = (nM - 4 * gi) < 4 ? (nM - 4 * gi) : 4;
        u.pn = rem / rows; u.pm = 4 * gi + rem % rows; return true;
    }
};
struct MoeOrder {
    const int* tile_e; int NT, ncol, G, c;
    __device__ __forceinline__ bool next(int i, Unit& u) const {
        const int nU = NT * ncol; long Q;
        if ((G & 7) == 0) { const int x = c & 7, l = c >> 3, W = G >> 3; const long s0 = (long)nU * x / 8, s1 = (long)nU * (x + 1) / 8; Q = s0 + (long)i * W + l; if (Q >= s1) return false; }
        else { Q = (long)i * G + c; if (Q >= nU) return false; }
        const int t = (int)(Q / ncol), j = (int)(Q % ncol); u.pm = t; u.pn = tile_e[t] * ncol + j; return true;
    }
};

#ifdef CPU_EMU
template <class Epi, class Sched>
__device__ __forceinline__ void gemm_phase(unsigned char* lds, const Gemm g, const Sched& S, const Epi& E) {
    const int tid = threadIdx.x, wid = tid >> 6, lane = tid & 63, wr = wid >> 2, wc = wid & 3, fr = lane & 15, fq = lane >> 4;
    Unit u;
    for (int ui = 0; S.next(ui, u); ++ui) {
        f32x4 acc[2][2][4][2];
        for (int ai = 0; ai < 2; ++ai) for (int m = 0; m < 4; ++m) {
            const int rr = 128 * ai + 64 * wr + 16 * m + fr;
            const size_t arow = g.rowidx ? (size_t)g.rowidx[256 * u.pm + rr] : (size_t)256 * u.pm + rr;
            const bf16_t* ap = g.A + arow * g.K;
            for (int bj = 0; bj < 2; ++bj) for (int n = 0; n < 2; ++n) for (int e = 0; e < 4; ++e) {
                const int col = 256 * u.pn + 128 * bj + 32 * wc + 8 * fq + 4 * n + e;
                const bf16_t* bp = g.Bt + (size_t)col * g.K;
                float s = 0.f; for (int k = 0; k < g.K; ++k) s += bf2f(ap[k]) * bf2f(bp[k]);
                acc[ai][bj][m][n][e] = s;
            }
        }
        E(acc, u, wr, wc, fr, fq);
    }
    (void)lds;
}
#else
template <class Epi, class Sched>
__device__ __forceinline__ void gemm_phase(LAS unsigned char* lds, const Gemm g, const Sched& S, const Epi& E) {
    const int tid = threadIdx.x, wid = __builtin_amdgcn_readfirstlane(tid >> 6), lane = tid & 63, wr = wid >> 2, wc = wid & 3, fr = lane & 15, fq = lane >> 4;
    const int K = g.K, nt = K / BK;
    int Rr[2], Cc[2];
    unsigned voffB[2];
#pragma unroll
    for (int i = 0; i < 2; ++i) { stage_rc(tid * 16 + i * 8192, Rr[i], Cc[i]); const int Rb = (Rr[i] & ~31) + perm32(Rr[i] & 31); voffB[i] = (unsigned)(Rb * K + Cc[i]) * 2u; }
    const size_t kstep = (size_t)(BK * 2);
    const size_t hstep = (size_t)HALF * K * 2;
    const size_t tstep = 2 * hstep;
    const unsigned ldsw = (unsigned)wid * 1024u;
    const int aoff = lds_byte(wr * 64 + fr, fq * 8), boff = lds_byte(wc * 32 + fr, fq * 8);
#define PG8_SA(b, h) (((b) * 2 + (h)) * HTB)
#define PG8_SB(b, h) ((4 + (b) * 2 + (h)) * HTB)
#define PG8_STAGE(bufoff, gbase, voff) do { _Pragma("unroll") for (int _i = 0; _i < 2; ++_i) \
        __builtin_amdgcn_global_load_lds((const unsigned*)((const char*)(gbase) + (voff)[_i]), (LAS unsigned*)(lds + (bufoff) + ldsw + _i * 8192), 16, 0, 0); } while (0)
#define PG8_LDA(dst, b, h) do { _Pragma("unroll") for (int m = 0; m < 4; ++m) _Pragma("unroll") for (int k = 0; k < 2; ++k) dst[m][k] = *(const LAS bf16x8*)(lds + PG8_SA(b, h) + aoff + m * 2048 + k * 1024); } while (0)
#define PG8_LDB(dst, b, h) do { _Pragma("unroll") for (int n = 0; n < 2; ++n) _Pragma("unroll") for (int k = 0; k < 2; ++k) dst[n][k] = *(const LAS bf16x8*)(lds + PG8_SB(b, h) + boff + n * 2048 + k * 1024); } while (0)
#define PG8_MMA(ai, bj, At, Bt) do { __builtin_amdgcn_s_setprio(1); _Pragma("unroll") for (int m = 0; m < 4; ++m) _Pragma("unroll") for (int n = 0; n < 2; ++n) _Pragma("unroll") for (int k = 0; k < 2; ++k) \
        acc[ai][bj][m][n] = __builtin_amdgcn_mfma_f32_16x16x32_bf16(Bt[n][k], At[m][k], acc[ai][bj][m][n], 0, 0, 0); __builtin_amdgcn_s_setprio(0); } while (0)
#define PG8_WAIT_V(n) asm volatile("s_waitcnt vmcnt(" #n ")" ::: "memory")
#define PG8_WAIT_L(n) asm volatile("s_waitcnt lgkmcnt(" #n ")" ::: "memory")
#define PG8_BAR __builtin_amdgcn_s_barrier()
#define PG8_SCHED __builtin_amdgcn_sched_barrier(0)
#define PG8_AOFF(dst, unit) do { _Pragma("unroll") for (int _h = 0; _h < 2; ++_h) _Pragma("unroll") for (int _i = 0; _i < 2; ++_i) { \
        const int _rr = _h * HALF + Rr[_i]; const unsigned _row = g.rowidx ? (unsigned)g.rowidx[(unit).pm * BM + _rr] : (unsigned)((unit).pm * BM + _rr); \
        dst[_h][_i] = (_row * (unsigned)K + (unsigned)Cc[_i]) * 2u; } } while (0)
    Unit cur, nxt; int ui = 0;
    if (!S.next(0, cur)) return;
    f32x4 acc[2][2][4][2];
#pragma unroll
    for (int a = 0; a < 2; ++a)
#pragma unroll
        for (int b = 0; b < 2; ++b)
#pragma unroll
            for (int m = 0; m < 4; ++m)
#pragma unroll
                for (int n = 0; n < 2; ++n) acc[a][b][m][n] = (f32x4){0.f, 0.f, 0.f, 0.f};
    bf16x8 At[4][2], B0[2][2], B1[2][2];
    unsigned oC[2][2], oN[2][2];
    PG8_AOFF(oC, cur);
    const char* const gA = (const char*)g.A;
    const char* cB = (const char*)g.Bt + (size_t)cur.pn * tstep;
    PG8_STAGE(PG8_SB(0, 0), cB, voffB); PG8_STAGE(PG8_SA(0, 0), gA, oC[0]); PG8_STAGE(PG8_SB(0, 1), cB + hstep, voffB); PG8_STAGE(PG8_SA(0, 1), gA, oC[1]);
    if (wr == 1) PG8_BAR;
    PG8_WAIT_V(4); PG8_BAR;
    PG8_STAGE(PG8_SB(1, 0), cB + kstep, voffB); PG8_STAGE(PG8_SA(1, 0), gA + kstep, oC[0]); PG8_STAGE(PG8_SB(1, 1), cB + hstep + kstep, voffB);
    PG8_WAIT_V(6); PG8_BAR;
    for (;;) {
        const bool has_next = S.next(ui + 1, nxt);
        if (has_next) { PG8_AOFF(oN, nxt); } else {
#pragma unroll
            for (int _h = 0; _h < 2; ++_h)
#pragma unroll
                for (int _i = 0; _i < 2; ++_i) oN[_h][_i] = oC[_h][_i]; }
        const char* nB = has_next ? (const char*)g.Bt + (size_t)nxt.pn * tstep : cB;
        for (int t = 0; t < nt; t += 2) {
            const bool last = (t == nt - 2);
            const char* a1 = gA + (size_t)(t + 1) * kstep;
            const char* a2 = last ? gA : gA + (size_t)(t + 2) * kstep; const char* b2 = last ? nB : cB + (size_t)(t + 2) * kstep;
            const char* a3 = a2 + kstep; const char* b3 = b2 + kstep;
            unsigned o2[2][2];
#pragma unroll
            for (int _h = 0; _h < 2; ++_h)
#pragma unroll
                for (int _i = 0; _i < 2; ++_i) o2[_h][_i] = last ? oN[_h][_i] : oC[_h][_i];
            PG8_LDB(B0, 0, 0); PG8_SCHED; PG8_LDA(At, 0, 0); PG8_STAGE(PG8_SA(1, 1), a1, oC[1]);
            PG8_WAIT_L(8); PG8_BAR; PG8_WAIT_L(0); PG8_MMA(0, 0, At, B0); PG8_BAR; PG8_SCHED;
            PG8_LDB(B1, 0, 1); PG8_STAGE(PG8_SB(0, 0), b2, voffB);
            PG8_BAR; PG8_WAIT_L(0); PG8_MMA(0, 1, At, B1); PG8_BAR;
            PG8_LDA(At, 0, 1); PG8_STAGE(PG8_SA(0, 0), a2, o2[0]);
            PG8_BAR; PG8_WAIT_L(0); PG8_MMA(1, 0, At, B0); PG8_BAR; PG8_SCHED;
            PG8_STAGE(PG8_SB(0, 1), b2 + hstep, voffB);
            PG8_WAIT_V(6); PG8_BAR; PG8_MMA(1, 1, At, B1); PG8_BAR;
            PG8_LDB(B0, 1, 0); PG8_SCHED; PG8_LDA(At, 1, 0); PG8_STAGE(PG8_SA(0, 1), a2, o2[1]);
            PG8_WAIT_L(8); PG8_BAR; PG8_WAIT_L(0); PG8_MMA(0, 0, At, B0); PG8_BAR; PG8_SCHED;
            PG8_LDB(B1, 1, 1); PG8_STAGE(PG8_SB(1, 0), b3, voffB);
            PG8_BAR; PG8_WAIT_L(0); PG8_MMA(0, 1, At, B1); PG8_BAR;
            PG8_LDA(At, 1, 1); PG8_STAGE(PG8_SA(1, 0), a3, o2[0]);
            PG8_BAR; PG8_WAIT_L(0); PG8_MMA(1, 0, At, B0); PG8_BAR; PG8_SCHED;
            PG8_STAGE(PG8_SB(1, 1), b3 + hstep, voffB);
            PG8_WAIT_V(6); PG8_BAR; PG8_MMA(1, 1, At, B1); PG8_BAR;
        }
        E(acc, cur, wr, wc, fr, fq);
        if (!has_next) break;
#pragma unroll
        for (int a = 0; a < 2; ++a)
#pragma unroll
            for (int b = 0; b < 2; ++b)
#pragma unroll
                for (int m = 0; m < 4; ++m)
#pragma unroll
                    for (int n = 0; n < 2; ++n) acc[a][b][m][n] = (f32x4){0.f, 0.f, 0.f, 0.f};
        cur = nxt; cB = nB; ++ui;
#pragma unroll
        for (int _h = 0; _h < 2; ++_h)
#pragma unroll
            for (int _i = 0; _i < 2; ++_i) oC[_h][_i] = oN[_h][_i];
    }
    PG8_WAIT_V(0);
    if (wr == 0) PG8_BAR;
    PG8_BAR;
#undef PG8_SA
#undef PG8_SB
#undef PG8_STAGE
#undef PG8_LDA
#undef PG8_LDB
#undef PG8_MMA
#undef PG8_WAIT_V
#undef PG8_WAIT_L
#undef PG8_BAR
#undef PG8_SCHED
#undef PG8_AOFF
}
#endif

struct EpiIn {
    bf16_t* P; int ldp; float* G; int np;
    __device__ __forceinline__ void operator()(const f32x4 (&acc)[2][2][4][2], const Unit& u, int wr, int wc, int fr, int fq) const {
        const int row0 = u.pm * BM + wr * 64 + fr;
        if (u.pn < np) {
            const int col0 = u.pn * BM + wc * 32 + 8 * fq;
#pragma unroll
            for (int ai = 0; ai < 2; ++ai)
#pragma unroll
                for (int m = 0; m < 4; ++m) { bf16_t* rowp = P + (size_t)(row0 + ai * HALF + m * 16) * ldp + col0;
#pragma unroll
                    for (int bj = 0; bj < 2; ++bj) { const f32x4 v0 = acc[ai][bj][m][0], v1 = acc[ai][bj][m][1];
                        u32x4 o; o[0] = pk2(v0[0], v0[1]); o[1] = pk2(v0[2], v0[3]); o[2] = pk2(v1[0], v1[1]); o[3] = pk2(v1[2], v1[3]);
                        *(u32x4*)(rowp + bj * HALF) = o; } }
        } else if (wc == 0) {
#pragma unroll
            for (int ai = 0; ai < 2; ++ai)
#pragma unroll
                for (int m = 0; m < 4; ++m) { float* rowp = G + (size_t)(row0 + ai * HALF + m * 16) * 32 + 8 * fq;
                    *(f32x4*)(rowp) = acc[ai][0][m][0]; *(f32x4*)(rowp + 4) = acc[ai][0][m][1]; }
        }
    }
};
struct EpiBf {
    bf16_t* O; int ldc;
    __device__ __forceinline__ void operator()(const f32x4 (&acc)[2][2][4][2], const Unit& u, int wr, int wc, int fr, int fq) const {
        const int row0 = u.pm * BM + wr * 64 + fr, col0 = u.pn * BM + wc * 32 + 8 * fq;
#pragma unroll
        for (int ai = 0; ai < 2; ++ai)
#pragma unroll
            for (int m = 0; m < 4; ++m) { bf16_t* rowp = O + (size_t)(row0 + ai * HALF + m * 16) * ldc + col0;
#pragma unroll
                for (int bj = 0; bj < 2; ++bj) { const f32x4 v0 = acc[ai][bj][m][0], v1 = acc[ai][bj][m][1];
                    u32x4 o; o[0] = pk2(v0[0], v0[1]); o[1] = pk2(v0[2], v0[3]); o[2] = pk2(v1[0], v1[1]); o[3] = pk2(v1[2], v1[3]);
                    *(u32x4*)(rowp + bj * HALF) = o; } }
    }
};
struct EpiMoe1 {
    bf16_t* H;
    __device__ __forceinline__ void operator()(const f32x4 (&acc)[2][2][4][2], const Unit& u, int wr, int wc, int fr, int fq) const {
        const int row0 = u.pm * BM + wr * 64 + fr, col0 = (u.pn & 3) * 128 + wc * 32 + 8 * fq;
#pragma unroll
        for (int ai = 0; ai < 2; ++ai)
#pragma unroll
            for (int m = 0; m < 4; ++m) { bf16_t* rowp = H + (size_t)(row0 + ai * HALF + m * 16) * DEXP + col0;
                float h[8];
#pragma unroll
                for (int n = 0; n < 2; ++n)
#pragma unroll
                    for (int e = 0; e < 4; ++e) h[4 * n + e] = siluf_(acc[ai][0][m][n][e]) * acc[ai][1][m][n][e];
                u32x4 o; o[0] = pk2(h[0], h[1]); o[1] = pk2(h[2], h[3]); o[2] = pk2(h[4], h[5]); o[3] = pk2(h[6], h[7]);
                *(u32x4*)rowp = o; }
    }
};
struct EpiMoe2 {
    bf16_t* Y; const float* slot_gate; int ncol;
    __device__ __forceinline__ void operator()(const f32x4 (&acc)[2][2][4][2], const Unit& u, int wr, int wc, int fr, int fq) const {
        const int row0 = u.pm * BM + wr * 64 + fr, col0 = (u.pn % ncol) * BM + wc * 32 + 8 * fq;
#pragma unroll
        for (int ai = 0; ai < 2; ++ai)
#pragma unroll
            for (int m = 0; m < 4; ++m) { const int row = row0 + ai * HALF + m * 16; bf16_t* rowp = Y + (size_t)row * D + col0;
#pragma unroll
                for (int bj = 0; bj < 2; ++bj) { const f32x4 v0 = acc[ai][bj][m][0], v1 = acc[ai][bj][m][1];
                    u32x4 o; o[0] = pk2(v0[0], v0[1]); o[1] = pk2(v0[2], v0[3]); o[2] = pk2(v1[0], v1[1]); o[3] = pk2(v1[2], v1[3]);
                    *(u32x4*)(rowp + bj * HALF) = o; } }
    }
};

#if defined(DIAG_SUB) && !defined(CPU_EMU)
#define DSUB_DECL unsigned long long dsub_t0 = 0
#define DSUB_BEGIN(id) do { if ((id) == DIAG_SUB && threadIdx.x == 0) dsub_t0 = wall_clock64(); } while (0)
#define DSUB_END(id) do { if ((id) == DIAG_SUB && threadIdx.x == 0) { volatile LAS unsigned long long* a_ = (volatile LAS unsigned long long*)((LAS unsigned char*)F.lds + 147456 - 32); *a_ = *a_ + (wall_clock64() - dsub_t0); } } while (0)
#else
#define DSUB_DECL do { } while (0)
#define DSUB_BEGIN(id) do { } while (0)
#define DSUB_END(id) do { } while (0)
#endif
struct Frame {
    const float* const* in; float* out; unsigned char* ws; unsigned char* lds;
    int tid, lane, wave, G, bid;
};
#define WSP(type, off) ((type*)(F.ws + (off)))
#define PAP(type, off) ((type*)(F.ws + WS_PA + (off)))

template <class Fetch4>
__device__ __forceinline__ void cvt_tile(const Frame& F, Fetch4 fetch4, bf16_t* dst, int dst_ld, int n0, int k0, int nvalid) {
    float* tile = (float*)F.lds;
    { const int n4 = (F.tid & 63) * 4, kk0 = F.tid >> 6; f32x4 v[8];
#pragma unroll
      for (int i = 0; i < 8; ++i) v[i] = fetch4(k0 + kk0 + 8 * i, n0 + n4);
#pragma unroll
      for (int i = 0; i < 8; ++i) { const int kk = kk0 + 8 * i; *(f32x4*)(tile + kk * 260 + (n4 ^ (4 * ((kk >> 3) & 7)))) = v[i]; } }
    __syncthreads();
#pragma unroll
    for (int i = 0; i < 4; ++i) { const int id = F.tid + NTHREADS * i, kc = id & 7, nn = id >> 3;
        if (nn < nvalid) { float x[8];
#pragma unroll
            for (int e = 0; e < 8; ++e) x[e] = tile[(kc * 8 + e) * 260 + (nn ^ (4 * kc))];
            u32x4 pk; pk[0] = pk2(x[0], x[1]); pk[1] = pk2(x[2], x[3]); pk[2] = pk2(x[4], x[5]); pk[3] = pk2(x[6], x[7]);
            *(u32x4*)(dst + (size_t)(n0 + nn) * dst_ld + k0 + kc * 8) = pk; } }
    __syncthreads();
}
__device__ __forceinline__ f32x4 ld4(const float* p) { return *(const f32x4*)p; }

__device__ __forceinline__ void moe_weight_cvt(const Frame& F, int l, unsigned* queue = nullptr) {
    const float* wg = F.in[28] + (size_t)l * NEXP * D * DEXP; const float* wu = F.in[29] + (size_t)l * NEXP * D * DEXP; const float* wd = F.in[30] + (size_t)l * NEXP * DEXP * D;
    bf16_t* W1 = WSP(bf16_t, WS_MOEW1); bf16_t* W2 = WSP(bf16_t, WS_MOEW2);
    constexpr int T1 = (1024 / 256) * (D / 64), T2 = (D / 256) * (DEXP / 64);
    const int ntile = NEXP * (T1 + T2);
    int* sNext = (int*)(F.lds + 66560 + 1024);
    for (int t = F.bid;; t += F.G) {
        if (queue) { __syncthreads(); if (F.tid == 0) {
#ifdef CPU_EMU
                *sNext = (int)atomicAdd(queue, 1u);
#else
                *sNext = (int)__hip_atomic_fetch_add(queue, 1u, __ATOMIC_RELAXED, __HIP_MEMORY_SCOPE_AGENT);
#endif
            } __syncthreads(); t = *sNext; }
        if (t >= ntile) break;
        const int e = t / (T1 + T2), r = t % (T1 + T2);
        if (r < T1) { const int nt_ = r / (D / 64), kt = r % (D / 64);
            const float* g_ = wg + (size_t)e * D * DEXP; const float* u_ = wu + (size_t)e * D * DEXP;
            cvt_tile(F, [=](int k, int n) { const int j = n >> 8, rho = n & 255; return rho < 128 ? ld4(g_ + (size_t)k * DEXP + 128 * j + rho) : ld4(u_ + (size_t)k * DEXP + 128 * j + rho - 128); },
                     W1 + (size_t)e * 1024 * D, D, nt_ * 256, kt * 64, 256);
        } else { const int r2 = r - T1, nt_ = r2 / (DEXP / 64), kt = r2 % (DEXP / 64);
            const float* d_ = wd + (size_t)e * DEXP * D;
            cvt_tile(F, [=](int k, int n) { return ld4(d_ + (size_t)k * D + n); }, W2 + (size_t)e * D * DEXP, DEXP, nt_ * 256, kt * 64, 256);
        }
    }
}

__device__ __forceinline__ void phase_prologue(const Frame& F) {
    {
        float* sS = (float*)F.lds;
        float* sRed = sS + 3 * D;
        float* MODS = WSP(float, WS_MODS);
        constexpr int NJB = 6 * D / 128;
        bool have = false;
        for (int u = F.bid; u < 2 * NJB; u += F.G) {
            if (!have) { for (int i = F.tid; i < 3 * D; i += NTHREADS) { const int r = i / D, k = i % D; const float c = r < 2 ? F.in[1][r * D + k] : F.in[3][k]; sS[i] = siluf_(c); } __syncthreads(); have = true; }
            const int l = u / NJB, jb = u % NJB;
            const int cg = F.tid & 31, kg = F.tid >> 5;
            const float* W = F.in[4] + (size_t)l * D * 6 * D + jb * 128 + cg * 4;
            float a[3][4];
#pragma unroll
            for (int r = 0; r < 3; ++r)
#pragma unroll
                for (int e = 0; e < 4; ++e) a[r][e] = 0.f;
#pragma unroll 8
            for (int k = kg; k < D; k += 16) { const f32x4 w = *(const f32x4*)(W + (size_t)k * 6 * D);
#pragma unroll
                for (int r = 0; r < 3; ++r) { const float s = sS[r * D + k];
#pragma unroll
                    for (int e = 0; e < 4; ++e) a[r][e] += s * w[e]; } }
#pragma unroll
            for (int r = 0; r < 3; ++r)
#pragma unroll
                for (int e = 0; e < 4; ++e) sRed[(kg * 3 + r) * 128 + cg * 4 + e] = a[r][e];
            __syncthreads();
            if (F.tid < 384) { const int r = F.tid >> 7, j = F.tid & 127; float s = 0.f;
#pragma unroll
                for (int q = 0; q < 16; ++q) s += sRed[(q * 3 + r) * 128 + j];
                MODS[((size_t)l * 3 + r) * 6 * D + jb * 128 + j] = s + F.in[5][(size_t)l * 6 * D + jb * 128 + j]; }
            __syncthreads();
        }
        __syncthreads();
    }
    {
        constexpr int KT = D / 64;
        constexpr int J0 = (NW0 / 256) * KT, J1 = (NW1 / 256) * KT, J2 = (D / 256) * (DMIX / 64), J3 = J2, J4 = 32 * 2, J5 = 2 * KT;
        constexpr int JT = J0 + J1 + J2 + J3 + J4 + J5;
        const f32x4 z4 = {0.f, 0.f, 0.f, 0.f};
        int* sNext = (int*)(F.lds + 66560 + 1024); unsigned* queue = (unsigned*)(F.ws + WS_CTL) + 24;
        for (;;) {
            __syncthreads();
            if (F.tid == 0) {
#ifdef CPU_EMU
                *sNext = (int)atomicAdd(queue, 1u);
#else
                *sNext = (int)__hip_atomic_fetch_add(queue, 1u, __ATOMIC_RELAXED, __HIP_MEMORY_SCOPE_AGENT);
#endif
            }
            __syncthreads();
            const int t = *sNext; if (t >= JT) break;
            int r = t;
            if (r < J0) { const int nt_ = r / KT, kt = r % KT; const float* src = F.in[8];
                cvt_tile(F, [=](int k, int n) { f32x4 v = z4; if (n < 3072) v = ld4(src + (size_t)k * 5152 + n); else if (n < 5120) v = ld4(src + (size_t)k * 5152 + n + 32); else if (n < 5152) v = ld4(src + (size_t)k * 5152 + n - 5120 + 3072);
                                                 return n < 512 ? v * 0.08838834764831845f : v; }, WSP(bf16_t, WS_WIN0), D, nt_ * 256, kt * 64, 256);
                continue; }
            r -= J0;
            if (r < J1) { const int nt_ = r / KT, kt = r % KT; const float* src = F.in[20];
                cvt_tile(F, [=](int k, int n) { f32x4 v = z4; if (n < 6176) v = ld4(src + (size_t)k * 6176 + n); return (n >= 1024 && n < 2048) ? v * 0.08838834764831845f : v; }, WSP(bf16_t, WS_WIN1), D, nt_ * 256, kt * 64, 256);
                continue; }
            r -= J1;
            if (r < J2 + J3) { const int which = r / J2; r %= J2; const int nt_ = r / (DMIX / 64), kt = r % (DMIX / 64); const float* src = F.in[which ? 23 : 19];
                cvt_tile(F, [=](int k, int n) { return ld4(src + (size_t)k * D + n); }, WSP(bf16_t, which ? WS_WOUT1 : WS_WOUT0), DMIX, nt_ * 256, kt * 64, 256);
                continue; }
            r -= J2 + J3;
            if (r < J4) { const int mat = r / 2, kt = r % 2; const int dir = mat >> 4, gate = (mat >> 3) & 1, nb = mat & 7;
                const float* src = F.in[gate ? 16 : 14] + ((size_t)dir * 8 + nb) * 128 * 128;
                cvt_tile(F, [=](int k, int n) { return n < 128 ? ld4(src + (size_t)k * 128 + n) : z4; }, WSP(bf16_t, WS_WLRU) + (size_t)mat * 128 * 128, 128, 0, kt * 64, 128);
                continue; }
            r -= J4;
            { const int l = r / KT, kt = r % KT; const float* wgp = F.in[24] + (size_t)l * D * 4; const float* wep = F.in[26] + (size_t)l * D * 32;
              cvt_tile(F, [=](int k, int n) { return n < 4 ? ld4(wgp + (size_t)k * 4) : (n < 36 ? ld4(wep + (size_t)k * 32 + n - 4) : z4); }, WSP(bf16_t, WS_WR) + (size_t)l * 48 * D, D, 0, kt * 64, 48); }
        }
    }
}

__device__ __forceinline__ void phase_modulate0(const Frame& F) {
    const float* MODS = WSP(float, WS_MODS);
    bf16_t* U = WSP(bf16_t, WS_ACT);
    constexpr size_t n4 = (size_t)T * D / 4;
    for (size_t i0 = (size_t)F.bid * NTHREADS * 4 + F.tid; i0 < n4; i0 += (size_t)F.G * NTHREADS * 4) {
        f32x4 x[4], sh[4], sc[4]; int row[4], col[4];
#pragma unroll
        for (int k = 0; k < 4; ++k) { const size_t i = i0 + (size_t)k * NTHREADS; if (i < n4) { row[k] = (int)(i / (D / 4)); col[k] = (int)(i % (D / 4)) * 4;
            const int r = row[k] < TL ? row[k] / SEQ : 2;
            const float* xr = row[k] < TL ? F.in[0] + (size_t)row[k] * D : F.in[2] + (size_t)(row[k] - TL) * D;
            x[k] = *(const f32x4*)(xr + col[k]); sh[k] = *(const f32x4*)(MODS + (size_t)r * 6 * D + col[k]); sc[k] = *(const f32x4*)(MODS + (size_t)r * 6 * D + D + col[k]); } }
#pragma unroll
        for (int k = 0; k < 4; ++k) { const size_t i = i0 + (size_t)k * NTHREADS; if (i < n4) {
            u32x2 o; o[0] = pk2(x[k][0] * (1.f + sc[k][0]) + sh[k][0], x[k][1] * (1.f + sc[k][1]) + sh[k][1]); o[1] = pk2(x[k][2] * (1.f + sc[k][2]) + sh[k][2], x[k][3] * (1.f + sc[k][3]) + sh[k][3]);
            *(u32x2*)(U + (size_t)row[k] * D + col[k]) = o; } }
    }
}

__device__ __forceinline__ float fast_log_sigmoid(float z) {
#ifdef CPU_EMU
    return log_sigmoidf_(z);
#else
    return fminf(z, 0.f) - __logf(1.f + __expf(-fabsf(z)));
#endif
}
__device__ __forceinline__ void gla_vg_load(const Frame& F, int ug, u32x4 (&pv)[4], float (&pg)[4]) {
    const int h = ug & 3, bc = ug >> 2, b = bc / NCH, c = bc % NCH, row0 = chunk_row0(b, c);
    const bf16_t* P = PAP(bf16_t, PA_P); const float* Gt = WSP(float, WS_G); const int tid = threadIdx.x;
#pragma unroll
    for (int i = 0; i < 4; ++i) { const int idx = tid + NTHREADS * i, s_ = idx >> 5, vc = idx & 31; pv[i] = *(const u32x4*)(P + (size_t)(row0 + s_) * NP0 + 1024 + h * 256 + vc * 8); }
#pragma unroll
    for (int i = 0; i < 4; ++i) { const int idx = tid + NTHREADS * i; pg[i] = Gt[(size_t)(row0 + (idx >> 5)) * 32 + (idx & 31)]; }
}
__device__ __forceinline__ void gla_prep_unit(const Frame& F, int ug, int ug_next, u32x4 (&pv)[4], float (&pg)[4]) {
    const int h = ug & 3, bc = ug >> 2, b = bc / NCH, c = bc % NCH, row0 = chunk_row0(b, c);
    const bf16_t* P = PAP(bf16_t, PA_P);
    float* sG = (float*)(F.lds + 0);
    float* sLa = (float*)(F.lds + 24576);
    bf16_t* sV = (bf16_t*)(F.lds + 24576);
    bf16_t* sQ = (bf16_t*)(F.lds + 58368);
    bf16_t* sKi = (bf16_t*)(F.lds + 75776);
    bf16_t* sKeT = (bf16_t*)(F.lds + 93184);
    float* sBl = (float*)(F.lds + 111616);
    float* sSeg = (float*)(F.lds + 112128);
    int tz = threadIdx.x; OPAQUE(tz);
    const int tid = tz, lane = tz & 63, w = RFL(tz >> 6);
    bf16x8 qr[2], kr[2]; float wa[16];
#pragma unroll
    for (int i = 0; i < 4; ++i) { const int idx = tid + NTHREADS * i, s_ = idx >> 5, vc = idx & 31; *(u32x4*)(sV + s_ * 264 + vc * 8) = pv[i]; }
#pragma unroll
    for (int i = 0; i < 2; ++i) { const int idx = tid + NTHREADS * i, t = idx >> 4, d0 = (idx & 15) * 8;
        qr[i] = *(const bf16x8*)(P + (size_t)(row0 + t) * NP0 + h * 128 + d0); kr[i] = *(const bf16x8*)(P + (size_t)(row0 + t) * NP0 + 512 + h * 128 + d0); }
#pragma unroll
    for (int i = 0; i < 4; ++i) sG[tid + NTHREADS * i] = pg[i];
    if (ug_next >= 0) gla_vg_load(F, ug_next, pv, pg);
#pragma unroll
    for (int r = 0; r < 16; ++r) wa[r] = F.in[9][(size_t)r * 512 + h * 128 + (tid & 127)];
    __syncthreads();
    { bf16_t* VT = PAP(bf16_t, PA0_VT) + (size_t)ug * 256 * 64;
#pragma unroll
      for (int i = 0; i < 4; ++i) { const int idx = tid + NTHREADS * i, v = idx >> 3, sc = idx & 7; bf16x8 o;
#pragma unroll
          for (int e = 0; e < 8; ++e) o[e] = (short)sV[(sc * 8 + e) * 264 + v];
          *(bf16x8*)(VT + v * 64 + sc * 8) = o; } }
    __syncthreads();
#pragma unroll 1
    for (int dir = 0; dir < 2; ++dir) {
        { const int d = tid & 127, tq = tid >> 7; const float bias = F.in[10][dir * 512 + h * 128 + d];
#pragma unroll 4
          for (int i = 0; i < 16; ++i) { const int t = tq * 16 + i; float z = bias;
#pragma unroll
              for (int r = 0; r < 16; ++r) z += sG[t * 32 + dir * 16 + r] * wa[r];
              sLa[t * 128 + d] = fast_log_sigmoid(z) * (1.f / 16.f); }
          if (dir == 0) {
#pragma unroll
              for (int r = 0; r < 16; ++r) wa[r] = F.in[9][((size_t)16 + r) * 512 + h * 128 + d]; } }
        __syncthreads();
        { const int d = tid & 127, sg = tid >> 7; float v[16]; float run = 0.f;
#pragma unroll
          for (int i = 0; i < 16; ++i) { const int p = 16 * sg + i, t = dir ? 63 - p : p; run += sLa[t * 128 + d]; v[i] = run; }
          sSeg[sg * 128 + d] = run;
          __syncthreads();
          float off = 0.f;
          for (int s2 = 0; s2 < sg; ++s2) off += sSeg[s2 * 128 + d];
#pragma unroll
          for (int i = 0; i < 16; ++i) { const int p = 16 * sg + i, t = dir ? 63 - p : p; sLa[t * 128 + d] = v[i] + off; }
          if (sg == 3) { const float et = fexp(run + off); sBl[d] = et; PAP(float, PA0_DEC)[((size_t)ug * 2 + dir) * 128 + d] = et; } }
        __syncthreads();
        { bf16_t* QD = PAP(bf16_t, PA0_QD) + (size_t)dir * T * 512;
#pragma unroll
          for (int i = 0; i < 2; ++i) { const int idx = tid + NTHREADS * i, t = idx >> 4, d0 = (idx & 15) * 8;
              float qd[8], ki[8];
#pragma unroll
              for (int e = 0; e < 8; ++e) { const float e1 = fexp(sLa[t * 128 + d0 + e]), e2 = 1.f / e1; const float kf = bf2f((bf16_t)kr[i][e]);
                  qd[e] = bf2f((bf16_t)qr[i][e]) * e1; ki[e] = kf * e2; sKeT[(d0 + e) * 72 + t] = f2bf(ki[e] * sBl[d0 + e]); }
              u32x4 pq, pk; pq[0] = pk2(qd[0], qd[1]); pq[1] = pk2(qd[2], qd[3]); pq[2] = pk2(qd[4], qd[5]); pq[3] = pk2(qd[6], qd[7]);
              pk[0] = pk2(ki[0], ki[1]); pk[1] = pk2(ki[2], ki[3]); pk[2] = pk2(ki[4], ki[5]); pk[3] = pk2(ki[6], ki[7]);
              *(u32x4*)(sQ + t * 136 + d0) = pq; *(u32x4*)(sKi + t * 136 + d0) = pk;
              *(u32x4*)(QD + (size_t)(row0 + t) * 512 + h * 128 + d0) = pq; } }
        __syncthreads();
        { const int mt = w & 3, nt0 = (w >> 2) * 2; bf16_t* ATT = PAP(bf16_t, PA0_ATT) + ((size_t)ug * 2 + dir) * 64 * 64;
          const int t = 16 * mt + (lane & 15);
#pragma unroll
          for (int nn = 0; nn < 2; ++nn) { const int nt_ = nt0 + nn; f32x4 acc = fzero4();
#pragma unroll
              for (int ks = 0; ks < 4; ++ks) acc = MFMA16(frag_l(sKi, 136, 16 * nt_, 32 * ks, lane), frag_l(sQ, 136, 16 * mt, 32 * ks, lane), acc);
              const int s0 = 16 * nt_ + 4 * (lane >> 4); float m4[4];
#pragma unroll
              for (int j = 0; j < 4; ++j) { const int s_ = s0 + j; const bool keep = dir == 0 ? (s_ <= t) : (s_ >= t); m4[j] = keep ? acc[j] : 0.f; }
              u32x2 pk; pk[0] = pk2(m4[0], m4[1]); pk[1] = pk2(m4[2], m4[3]); *(u32x2*)(ATT + t * 64 + s0) = pk; }
          bf16_t* KE = PAP(bf16_t, PA0_KE) + ((size_t)ug * 2 + dir) * 128 * 64;
#pragma unroll
          for (int i = 0; i < 2; ++i) { const int idx = tid + NTHREADS * i, d = idx >> 3, sc = idx & 7; *(u32x4*)(KE + d * 64 + sc * 8) = *(const u32x4*)(sKeT + d * 72 + sc * 8); } }
        __syncthreads();
    }
}

__device__ __forceinline__ void unpack8(const u32x4 x, float (&f)[8]);
__device__ __forceinline__ void lru_tile_load(const Frame& F, int ul, u32x4 (&tr)[3]) {
    const int nb = ul & 7, bc = ul >> 3, b = bc / NCH, c = bc % NCH;
    const int pos0 = c < NCH_C ? 64 * c : 64 * (c - NCH_C), seqlen = c < NCH_C ? CTX : SEQ, rbase = c < NCH_C ? TL + b * CTX : b * SEQ;
    const bf16_t* P = PAP(bf16_t, PA_P);
#pragma unroll
    for (int i = 0; i < 3; ++i) { const int idx = (int)threadIdx.x + NTHREADS * i, rr = idx >> 4, cc = idx & 15, pos = pos0 + rr - 2; u32x4 x = {0u, 0u, 0u, 0u};
        if (idx < 67 * 16 && pos >= 0 && pos < seqlen) x = *(const u32x4*)(P + (size_t)(rbase + pos) * NP0 + 3072 + nb * 128 + cc * 8);
        tr[i] = x; }
}
__device__ __forceinline__ void lru_prep_unit(const Frame& F, int ul, int ul_next, u32x4 (&tr)[3]) {
    const int nb = ul & 7, bc = ul >> 3, b = bc / NCH, c = bc % NCH, row0 = chunk_row0(b, c);
    float* sX = (float*)(F.lds + 0);
    float* sA = sX;
    bf16_t* sXcb = (bf16_t*)(F.lds + 34816);
    float* sU = (float*)(F.lds + 52224);
    float* sH = (float*)(F.lds + 84992);
    float* sSegA = (float*)(F.lds + 117760);
    float* sSegH = (float*)(F.lds + 119808);
    int tz = threadIdx.x; OPAQUE(tz);
    const int tid = tz, lane = tz & 63, w = RFL(tz >> 6);
    bf16x8 wr[4], wi[4];
    { const bf16_t* Wr = WSP(bf16_t, WS_WLRU) + (size_t)(0 * 8 + nb) * 128 * 128; const bf16_t* Wi = WSP(bf16_t, WS_WLRU) + (size_t)(1 * 8 + nb) * 128 * 128;
#pragma unroll
      for (int ks = 0; ks < 4; ++ks) { wr[ks] = frag(Wr, 128, 16 * w, 32 * ks, lane); wi[ks] = frag(Wi, 128, 16 * w, 32 * ks, lane); } }
#pragma unroll
    for (int i = 0; i < 3; ++i) { const int idx = tid + NTHREADS * i; if (idx < 67 * 16) { float x8[8]; unpack8(tr[i], x8); const int rr = idx >> 4, cc = idx & 15;
#pragma unroll
        for (int e = 0; e < 8; ++e) sX[rr * 128 + cc * 8 + e] = x8[e]; } }
    if (ul_next >= 0) lru_tile_load(F, ul_next, tr);
    __syncthreads();
    { const int ch = tid & 127, tq = tid >> 7; const float cb = F.in[13][nb * 128 + ch];
      float cw[4];
#pragma unroll
      for (int j = 0; j < 4; ++j) cw[j] = F.in[12][j * 1024 + nb * 128 + ch];
#pragma unroll 4
      for (int i = 0; i < 16; ++i) { const int t = tq * 16 + i; float xc = cb;
#pragma unroll
          for (int j = 0; j < 4; ++j) xc += sX[(t + j) * 128 + ch] * cw[j];
          sXcb[t * 136 + ch] = f2bf(xc); } }
    __syncthreads();
#pragma unroll 1
    for (int dir = 0; dir < 2; ++dir) {
        { f32x4 ar[4], ai_[4];
#pragma unroll
          for (int m = 0; m < 4; ++m) { ar[m] = fzero4(); ai_[m] = fzero4(); }
          const int d = 16 * w + (lane & 15), ch = nb * 128 + d;
          const float brb = F.in[15][dir * 1024 + ch], bib = F.in[17][dir * 1024 + ch], lam = F.in[18][dir * 1024 + ch];
#pragma unroll
          for (int ks = 0; ks < 4; ++ks) { bf16x8 a4[4];
#pragma unroll
              for (int m = 0; m < 4; ++m) a4[m] = frag_l(sXcb, 136, 16 * m, 32 * ks, lane);
#pragma unroll
              for (int m = 0; m < 4; ++m) { ar[m] = MFMA16(a4[m], wr[ks], ar[m]); ai_[m] = MFMA16(a4[m], wi[ks], ai_[m]); } }
          if (dir == 0) { const bf16_t* Wr = WSP(bf16_t, WS_WLRU) + (size_t)(2 * 8 + nb) * 128 * 128; const bf16_t* Wi = WSP(bf16_t, WS_WLRU) + (size_t)(3 * 8 + nb) * 128 * 128;
#pragma unroll
              for (int ks = 0; ks < 4; ++ks) { wr[ks] = frag(Wr, 128, 16 * w, 32 * ks, lane); wi[ks] = frag(Wi, 128, 16 * w, 32 * ks, lane); } }
          const float lsl8 = 8.f * fast_log_sigmoid(lam);
#pragma unroll
          for (int m = 0; m < 4; ++m)
#pragma unroll
              for (int j = 0; j < 4; ++j) { const int t = 16 * m + 4 * (lane >> 4) + j;
                  const float r = 1.f / (1.f + fexp(-(ar[m][j] + brb))), ig = 1.f / (1.f + fexp(-(ai_[m][j] + bib))), a = fexp(r * lsl8);
                  const float u = sqrtf(fmaxf(1.f - a * a, 0.f)) * ig * bf2f(sXcb[t * 136 + d]);
                  sA[t * 128 + d] = a; sU[t * 128 + d] = u; } }
        __syncthreads();
        { const int ch = tid & 127, sg = tid >> 7; float hl[16], ac[16]; float hh = 0.f, A = 1.f;
#pragma unroll
          for (int i = 0; i < 16; ++i) { const int p = 16 * sg + i, t = dir ? 63 - p : p; const float a = sA[t * 128 + ch]; hh = a * hh + sU[t * 128 + ch]; A *= a; hl[i] = hh; ac[i] = A; }
          sSegA[sg * 128 + ch] = A; sSegH[sg * 128 + ch] = hh;
          __syncthreads();
          const size_t ix = (((size_t)dir * BATCH + b) * NCH + c) * 1024 + nb * 128 + ch;
          float st = 0.f, ap = 1.f;
          for (int s2 = 0; s2 < sg; ++s2) { st = sSegA[s2 * 128 + ch] * st + sSegH[s2 * 128 + ch]; ap *= sSegA[s2 * 128 + ch]; }
          if (sg == 3) { PAP(float, PA0_AT)[ix] = ap * A; PAP(float, PA0_HT)[ix] = A * st + hh; }
#pragma unroll
          for (int i = 0; i < 16; ++i) { const int p = 16 * sg + i, t = dir ? 63 - p : p; const float hv = hl[i] + ac[i] * st; sA[t * 128 + ch] = ap * ac[i]; if (dir == 0) sH[t * 128 + ch] = hv; else sH[t * 128 + ch] += hv; } }
        __syncthreads();
        { bf16_t* AC = PAP(bf16_t, dir ? PA0_ACB : PA0_ACF); bf16_t* HL = PAP(bf16_t, PA0_HL);
#pragma unroll
          for (int i = 0; i < 2; ++i) { const int idx = tid + NTHREADS * i, t = idx >> 4, c0 = (idx & 15) * 8;
              u32x4 oa; oa[0] = pk2(sA[t * 128 + c0], sA[t * 128 + c0 + 1]); oa[1] = pk2(sA[t * 128 + c0 + 2], sA[t * 128 + c0 + 3]); oa[2] = pk2(sA[t * 128 + c0 + 4], sA[t * 128 + c0 + 5]); oa[3] = pk2(sA[t * 128 + c0 + 6], sA[t * 128 + c0 + 7]);
              *(u32x4*)(AC + (size_t)(row0 + t) * 1024 + nb * 128 + c0) = oa;
              if (dir == 1) { u32x4 oh; oh[0] = pk2(sH[t * 128 + c0], sH[t * 128 + c0 + 1]); oh[1] = pk2(sH[t * 128 + c0 + 2], sH[t * 128 + c0 + 3]); oh[2] = pk2(sH[t * 128 + c0 + 4], sH[t * 128 + c0 + 5]); oh[3] = pk2(sH[t * 128 + c0 + 6], sH[t * 128 + c0 + 7]);
                  *(u32x4*)(HL + (size_t)(row0 + t) * 1024 + nb * 128 + c0) = oh; } } }
        __syncthreads();
    }
}

__device__ __forceinline__ void phase_prep0(const Frame& F) {
    DSUB_DECL;
    DSUB_BEGIN(11);
    { u32x4 pv[4]; float pg[4];
      if (F.bid < NU_GLA) gla_vg_load(F, F.bid, pv, pg);
      for (int u = F.bid; u < NU_GLA; u += F.G) gla_prep_unit(F, u, (u + F.G < NU_GLA) ? u + F.G : -1, pv, pg); }
    __syncthreads();
    DSUB_END(11);
    DSUB_BEGIN(12);
    { u32x4 tr[3]; const int u0 = (F.bid + F.G - NU_GLA % F.G) % F.G;
      if (u0 < NU_LRU) lru_tile_load(F, u0, tr);
      for (int u = u0; u < NU_LRU; u += F.G) lru_prep_unit(F, u, (u + F.G < NU_LRU) ? u + F.G : -1, tr); }
    DSUB_END(12);
}

template <int NVT> struct Eng {
    static constexpr int VROWS = 16 * NVT, VPIECES = VROWS * 8, NPV = (VPIECES + NTHREADS - 1) / NTHREADS;
    static constexpr int OFF_S = 0, OFF_V = VROWS * 136 * 2, OFF_K = OFF_V + VROWS * 72 * 2, OFF_X = OFF_K + 128 * 72 * 2;
    static_assert(OFF_X + 2048 <= 147456 - 16, "LDS");
    __device__ static __forceinline__ void load_vk(u32x4 (&pfV)[NPV], u32x4 (&pfK)[2], const bf16_t* VT, const bf16_t* KE, int tid) {
#pragma unroll
        for (int i = 0; i < NPV; ++i) { const int idx = tid + NTHREADS * i; if (NPV * NTHREADS == VPIECES || idx < VPIECES) pfV[i] = *(const u32x4*)(VT + (size_t)idx * 8); }
#pragma unroll
        for (int i = 0; i < 2; ++i) pfK[i] = *(const u32x4*)(KE + (size_t)(tid + NTHREADS * i) * 8);
    }
    __device__ static __forceinline__ void stage_vk(const u32x4 (&pfV)[NPV], const u32x4 (&pfK)[2], bf16_t* sV, bf16_t* sKe, int tid) {
#pragma unroll
        for (int i = 0; i < NPV; ++i) { const int idx = tid + NTHREADS * i; if (NPV * NTHREADS == VPIECES || idx < VPIECES) *(LAS u32x4*)((LAS bf16_t*)sV + (idx >> 3) * 72 + (idx & 7) * 8) = pfV[i]; }
#pragma unroll
        for (int i = 0; i < 2; ++i) { const int idx = tid + NTHREADS * i; *(LAS u32x4*)((LAS bf16_t*)sKe + (idx >> 3) * 72 + (idx & 7) * 8) = pfK[i]; }
    }
    template <class DecT>
    __device__ static __forceinline__ void update(f32x4 (&acc)[NVT], const bf16_t* sV, const bf16_t* sKe, DecT dec, int w, int lane) {
        const bf16x8 a0 = frag_l(sKe, 72, 16 * w, 0, lane), a1 = frag_l(sKe, 72, 16 * w, 32, lane);
#pragma unroll
        for (int v0 = 0; v0 < NVT; v0 += 4) { bf16x8 bb[8];
#pragma unroll
            for (int k = 0; k < 4; ++k) if (v0 + k < NVT) { bb[2 * k] = frag_l(sV, 72, 16 * (v0 + k), 0, lane); bb[2 * k + 1] = frag_l(sV, 72, 16 * (v0 + k), 32, lane); }
            SCHED_BAR();
#pragma unroll
            for (int k = 0; k < 4; ++k) if (v0 + k < NVT) { acc[v0 + k] = acc[v0 + k] * dec; acc[v0 + k] = MFMA16(a0, bb[2 * k], acc[v0 + k]); }
#pragma unroll
            for (int k = 0; k < 4; ++k) if (v0 + k < NVT) acc[v0 + k] = MFMA16(a1, bb[2 * k + 1], acc[v0 + k]);
            SCHED_BAR(); }
    }
    __device__ static __forceinline__ void to_lds(const f32x4 (&acc)[NVT], bf16_t* sS, int w, int lane) {
#pragma unroll
        for (int vt = 0; vt < NVT; ++vt) { u32x2 pk; pk[0] = pk2(acc[vt][0], acc[vt][1]); pk[1] = pk2(acc[vt][2], acc[vt][3]);
            *(LAS u32x2*)((LAS bf16_t*)sS + (16 * vt + (lane & 15)) * 136 + 16 * w + 4 * (lane >> 4)) = pk; }
    }
    __device__ static __forceinline__ void gather(f32x4 (&acc)[NVT], const bf16_t* sS, int w, int lane) {
#pragma unroll
        for (int vt = 0; vt < NVT; ++vt) { const u32x2 pk = *(const LAS u32x2*)((const LAS bf16_t*)sS + (16 * vt + (lane & 15)) * 136 + 16 * w + 4 * (lane >> 4));
            acc[vt][0] = bf2f((bf16_t)(pk[0] & 0xffffu)); acc[vt][1] = bf2f((bf16_t)(pk[0] >> 16)); acc[vt][2] = bf2f((bf16_t)(pk[1] & 0xffffu)); acc[vt][3] = bf2f((bf16_t)(pk[1] >> 16)); }
    }
    __device__ static __forceinline__ void fill_state(bf16_t* sS, const bf16_t* SB, bool zero, int tid) {
        OPAQUE(tid);
        for (int idx = tid; idx < VROWS * 16; idx += NTHREADS) { const int v = idx >> 4, d0 = (idx & 15) * 8; u32x4 x = {0u, 0u, 0u, 0u}; if (!zero) x = *(const u32x4*)(SB + v * 128 + d0); *(LAS u32x4*)((LAS bf16_t*)sS + v * 136 + d0) = x; }
    }
    __device__ static __forceinline__ void fill_state_dma(bf16_t* sS, const bf16_t* SB, bool zero, int tid, int w, int lane) {
        if (zero) { for (int idx = tid; idx < VROWS * 16; idx += NTHREADS) { const u32x4 z = {0u, 0u, 0u, 0u}; *(LAS u32x4*)((LAS bf16_t*)sS + (idx >> 4) * 136 + (idx & 15) * 8) = z; } return; }
#ifdef CPU_EMU
        (void)w; (void)lane; for (int idx = tid; idx < VROWS * 16; idx += NTHREADS) { const int v = idx >> 4, d0 = (idx & 15) * 8; *(u32x4*)(sS + v * 136 + d0) = *(const u32x4*)(SB + v * 128 + d0); }
#else
        for (int r = w; r < VROWS; r += NTHREADS / 64)
            __builtin_amdgcn_global_load_lds((const unsigned*)(SB + (size_t)r * 128 + 2 * lane), (LAS unsigned*)((LAS bf16_t*)sS + r * 136), 4, 0, 0);
#endif
    }
    __device__ static __forceinline__ void load_state(f32x4 (&acc)[NVT], bf16_t* sS, const bf16_t* SB, bool zero, int tid, int w, int lane) {
        for (int idx = tid; idx < VROWS * 16; idx += NTHREADS) { const int v = idx >> 4, d0 = (idx & 15) * 8; u32x4 x = {0u, 0u, 0u, 0u}; if (!zero) x = *(const u32x4*)(SB + v * 128 + d0); *(LAS u32x4*)((LAS bf16_t*)sS + v * 136 + d0) = x; }
        __syncthreads();
#pragma unroll
        for (int vt = 0; vt < NVT; ++vt) { const u32x2 pk = *(const LAS u32x2*)((const LAS bf16_t*)sS + (16 * vt + (lane & 15)) * 136 + 16 * w + 4 * (lane >> 4));
            acc[vt][0] = bf2f((bf16_t)(pk[0] & 0xffffu)); acc[vt][1] = bf2f((bf16_t)(pk[0] >> 16)); acc[vt][2] = bf2f((bf16_t)(pk[1] & 0xffffu)); acc[vt][3] = bf2f((bf16_t)(pk[1] >> 16)); }
    }
    __device__ static __forceinline__ void store_state(const bf16_t* sS, bf16_t* KVG, int tid) {
        for (int idx = tid; idx < VROWS * 16; idx += NTHREADS) { const int v = idx >> 4, d0 = (idx & 15) * 8; *(u32x4*)(KVG + v * 128 + d0) = *(const LAS u32x4*)((const LAS bf16_t*)sS + v * 136 + d0); }
    }
};

__device__ __forceinline__ void phase_agg0(const Frame& F) {
    const int tid = F.tid, lane = F.lane, w = F.wave;
    { constexpr int RUN = (NCH + 7) / 8; float* sRA = (float*)F.lds; float* sRH = sRA + 8 * 64;
      const float* AT = PAP(float, PA0_AT); const float* HT = PAP(float, PA0_HT); float* HIN = PAP(float, PA0_HIN);
      for (int u = F.bid; u < 2 * BATCH * 16; u += F.G) { const int dir = u / (BATCH * 16), b = (u / 16) % BATCH, ch = (u % 16) * 64 + lane;
          const int i0 = w * RUN, i1 = (i0 + RUN < NCH) ? i0 + RUN : NCH;
          float A = 1.f, H = 0.f;
#pragma unroll 8
          for (int i = i0; i < i1; ++i) { const size_t ix = (((size_t)dir * BATCH + b) * NCH + scan_chunk(dir, i)) * 1024 + ch; const float a = AT[ix]; H = a * H + HT[ix]; A *= a; }
          sRA[w * 64 + lane] = A; sRH[w * 64 + lane] = H;
          __syncthreads();
          float st = 0.f;
          for (int w2 = 0; w2 < w; ++w2) st = sRA[w2 * 64 + lane] * st + sRH[w2 * 64 + lane];
#pragma unroll 8
          for (int i = i0; i < i1; ++i) { const size_t ix = (((size_t)dir * BATCH + b) * NCH + scan_chunk(dir, i)) * 1024 + ch; const float a = AT[ix], hh = HT[ix]; HIN[ix] = st; st = a * st + hh; }
          __syncthreads(); } }
    typedef Eng<16> E;
    bf16_t* sS = (bf16_t*)(F.lds + E::OFF_S); bf16_t* sV = (bf16_t*)(F.lds + E::OFF_V); bf16_t* sKe = (bf16_t*)(F.lds + E::OFF_K);
    constexpr int NUA = BATCH * NGRP * 8;
    u32x4 pfV[E::NPV], pfK[2]; f32x4 decn;
#define AGG0_LOAD(uu, jj) do { const int h_ = (uu) & 3, b_ = ((uu) >> 2) & 1, dir_ = ((uu) >> 3) & 1, g_ = (uu) >> 4; const int ug_ = (b_ * NCH + group_chunk(g_, dir_, (jj))) * 4 + h_; \
        E::load_vk(pfV, pfK, PAP(bf16_t, PA0_VT) + (size_t)ug_ * 256 * 64, PAP(bf16_t, PA0_KE) + ((size_t)ug_ * 2 + dir_) * 128 * 64, tid); \
        decn = *(const f32x4*)(PAP(float, PA0_DEC) + ((size_t)ug_ * 2 + dir_) * 128 + 16 * w + 4 * (lane >> 4)); } while (0)
    if (F.bid < NUA) AGG0_LOAD(F.bid, 0);
    for (int u = F.bid; u < NUA; u += F.G) {
        const int h = u & 3, b = (u >> 2) & 1, dir = (u >> 3) & 1, g = u >> 4, scan = (b * 4 + h) * 2 + dir;
        f32x4 acc[16];
#pragma unroll
        for (int vt = 0; vt < 16; ++vt) acc[vt] = fzero4();
        f32x4 decp = {1.f, 1.f, 1.f, 1.f};
        for (int j = 0; j < GC; ++j) {
            __syncthreads();
            E::stage_vk(pfV, pfK, sV, sKe, tid);
            const f32x4 dec = decn;
            __syncthreads();
            if (j + 1 < GC) AGG0_LOAD(u, j + 1); else if (u + F.G < NUA) AGG0_LOAD(u + F.G, 0);
            E::update(acc, sV, sKe, dec, w, lane);
            decp = decp * dec; }
        MFMA_DRAIN();
        E::to_lds(acc, sS, w, lane);
        if ((lane & 15) == 0) *(f32x4*)(PAP(float, PA0_DECG) + ((size_t)scan * NGRP + g) * 128 + 16 * w + 4 * (lane >> 4)) = decp;
        __syncthreads();
        E::store_state(sS, PAP(bf16_t, PA0_KVG) + ((size_t)scan * NGRP + g) * 32768, tid);
    }
#undef AGG0_LOAD
}

template <int NSCAN, int ELEMS, bool VEC>
__device__ __forceinline__ void group_scan(const Frame& F, bf16_t* KVG, const float* DECG) {
    constexpr int E4 = ELEMS / 4;
    for (int idx = F.bid * NTHREADS + F.tid; idx < NSCAN * E4; idx += F.G * NTHREADS) {
        const int scan = idx / E4, e4 = idx % E4, d0 = (e4 & 31) * 4, dir = scan & 1;
        bf16_t* base = KVG + (size_t)scan * NGRP * ELEMS + (size_t)e4 * 4; const float* dbase = DECG + (size_t)scan * NGRP * (VEC ? 128 : 1) + (VEC ? d0 : 0);
        float s4[4] = {0.f, 0.f, 0.f, 0.f};
        u32x2 kvb[8]; f32x4 dcb[8];
#pragma unroll
        for (int k = 0; k < 8; ++k) if (k < NGRP) { const int g = scan_group(dir, k); kvb[k] = *(const u32x2*)(base + (size_t)g * ELEMS);
            if (VEC) dcb[k] = *(const f32x4*)(dbase + (size_t)g * 128); else { const float x = dbase[g]; dcb[k] = (f32x4){x, x, x, x}; } }
        for (int i0 = 0; i0 < NGRP; i0 += 8) {
#pragma unroll
            for (int k = 0; k < 8; ++k) { const int i = i0 + k; if (i < NGRP) { const int g = scan_group(dir, i); const u32x2 kv = kvb[k]; const f32x4 dc = dcb[k];
                if (i + 8 < NGRP) { const int g2 = scan_group(dir, i + 8); kvb[k] = *(const u32x2*)(base + (size_t)g2 * ELEMS);
                    if (VEC) dcb[k] = *(const f32x4*)(dbase + (size_t)g2 * 128); else { const float x = dbase[g2]; dcb[k] = (f32x4){x, x, x, x}; } }
                u32x2 o; o[0] = pk2(s4[0], s4[1]); o[1] = pk2(s4[2], s4[3]); *(u32x2*)(base + (size_t)g * ELEMS) = o;
                s4[0] = dc[0] * s4[0] + bf2f((bf16_t)(kv[0] & 0xffffu)); s4[1] = dc[1] * s4[1] + bf2f((bf16_t)(kv[0] >> 16));
                s4[2] = dc[2] * s4[2] + bf2f((bf16_t)(kv[1] & 0xffffu)); s4[3] = dc[3] * s4[3] + bf2f((bf16_t)(kv[1] >> 16)); } }
        }
    }
}
__device__ __forceinline__ void phase_gscan0(const Frame& F) { group_scan<16, 32768, true>(F, PAP(bf16_t, PA0_KVG), PAP(float, PA0_DECG)); }

__device__ __forceinline__ void o_to_lds(const f32x4 (&o)[8], bf16_t* sO, int mt, int vh, int lane) {
    LAS bf16_t* p = (LAS bf16_t*)sO + (16 * mt + (lane & 15)) * 264 + 128 * vh + 4 * (lane >> 4);
#pragma unroll
    for (int i = 0; i < 8; ++i) { u32x2 pk; pk[0] = pk2(o[i][0], o[i][1]); pk[1] = pk2(o[i][2], o[i][3]); *(LAS u32x2*)(p + 16 * i) = pk; }
}
__device__ __forceinline__ float half_wave_sum(float v) { v += __shfl_xor(v, 16); v += __shfl_xor(v, 8); v += __shfl_xor(v, 4); v += __shfl_xor(v, 2); v += __shfl_xor(v, 1); return v; }
__device__ __forceinline__ void unpack8(const u32x4 x, float (&f)[8]) {
#pragma unroll
    for (int e = 0; e < 4; ++e) { f[2 * e] = bf2f((bf16_t)(x[e] & 0xffffu)); f[2 * e + 1] = bf2f((bf16_t)(x[e] >> 16)); }
}
__device__ __forceinline__ void gla_out_unit(const Frame& F, int u, int u_next, bool have_state) {
    typedef Eng<16> E;
    const int h = u & 3, bg = u >> 2, b = bg / NGRP, g = bg % NGRP;
    int tz0 = threadIdx.x; OPAQUE(tz0);
    const int tid = tz0, lane = tz0 & 63, w = RFL(tz0 >> 6), mt = w & 3, vh = w >> 2;
    bf16_t* sS = (bf16_t*)(F.lds + E::OFF_S); bf16_t* sV = (bf16_t*)(F.lds + E::OFF_V); bf16_t* sKe = (bf16_t*)(F.lds + E::OFF_K);
    bf16_t* sO = sV;
    const bf16_t* P = PAP(bf16_t, PA_P); bf16_t* Mix = WSP(bf16_t, WS_ACT);
#pragma unroll 1
    for (int dir = 0; dir < 2; ++dir) {
        const int scan = (b * 4 + h) * 2 + dir; const bool first = (g == scan_group(dir, 0));
        const bf16_t* QD = PAP(bf16_t, PA0_QD) + (size_t)dir * T * 512 + h * 128;
        u32x4 pfV[E::NPV], pfK[2]; bf16x8 aAtt[2], aQ[4]; f32x4 decn;
#define GLA_PTRS(jx) const int c_ = group_chunk(g, dir, (jx)), ug_ = (b * NCH + c_) * 4 + h, row0_ = chunk_row0(b, c_); \
        const bf16_t* VT_ = PAP(bf16_t, PA0_VT) + (size_t)ug_ * 256 * 64; const bf16_t* KE_ = PAP(bf16_t, PA0_KE) + ((size_t)ug_ * 2 + dir) * 128 * 64; \
        const bf16_t* ATT_ = PAP(bf16_t, PA0_ATT) + ((size_t)ug_ * 2 + dir) * 64 * 64;
#define GLA_LOAD_A() do { _Pragma("unroll") for (int ks = 0; ks < 2; ++ks) aAtt[ks] = frag(ATT_, 64, 16 * mt, 32 * ks, lane); \
        _Pragma("unroll") for (int ks = 0; ks < 4; ++ks) aQ[ks] = frag(QD + (size_t)row0_ * 512, 512, 16 * mt, 32 * ks, lane); \
        decn = *(const f32x4*)(PAP(float, PA0_DEC) + ((size_t)ug_ * 2 + dir) * 128 + 16 * w + 4 * (lane >> 4)); } while (0)
        { GLA_PTRS(0) E::load_vk(pfV, pfK, VT_, KE_, tid); (void)ATT_; (void)row0_; }
        if (dir == 0 && !have_state) { __syncthreads(); E::fill_state(sS, PAP(bf16_t, PA0_KVG) + ((size_t)scan * NGRP + g) * 32768, first, tid); }
        else {
#ifndef CPU_EMU
            asm volatile("s_waitcnt vmcnt(0)" ::: "memory");
#endif
        }
        const bf16_t* nSB = nullptr; bool nzero = false, nhave = false;
        if (dir == 0) { nSB = PAP(bf16_t, PA0_KVG) + ((size_t)(scan + 1) * NGRP + g) * 32768; nzero = (g == scan_group(1, 0)); nhave = true; }
        else if (u_next >= 0) { const int h2 = u_next & 3, bg2 = u_next >> 2, b2 = bg2 / NGRP, g2 = bg2 % NGRP; nSB = PAP(bf16_t, PA0_KVG) + ((size_t)((b2 * 4 + h2) * 2) * NGRP + g2) * 32768; nzero = (g2 == scan_group(0, 0)); nhave = true; }
#pragma unroll 1
        for (int j = 0; j < GC; ++j) {
            const int c = group_chunk(g, dir, j), row0 = chunk_row0(b, c);
            int tz = threadIdx.x; OPAQUE(tz);
            const int tid = tz, lane = tz & 63, w = RFL(tz >> 6), mt = w & 3, vh = w >> 2;
            { GLA_PTRS(j) (void)VT_; (void)KE_; GLA_LOAD_A(); }
            __syncthreads();
            E::stage_vk(pfV, pfK, sV, sKe, tid);
            bf16x8 cAtt[2], cQ[4];
#pragma unroll
            for (int ks = 0; ks < 2; ++ks) cAtt[ks] = aAtt[ks];
#pragma unroll
            for (int ks = 0; ks < 4; ++ks) cQ[ks] = aQ[ks];
            const f32x4 dec = decn;
            __syncthreads();
            u32x4 part[4], gate[4];
            if (dir == 1) {
#pragma unroll
                for (int i = 0; i < 4; ++i) { const int id = tid + NTHREADS * i, row = id >> 5, c8 = (id & 31) * 8;
                    part[i] = *(const u32x4*)(Mix + (size_t)(row0 + row) * DMIX + h * 256 + c8); gate[i] = *(const u32x4*)(P + (size_t)(row0 + row) * NP0 + 2048 + h * 256 + c8); } }
            f32x4 o[8];
#pragma unroll
            for (int i = 0; i < 8; ++i) o[i] = fzero4();
#pragma unroll
            for (int ks = 0; ks < 2; ++ks) { bf16x8 bb[8];
#pragma unroll
                for (int i = 0; i < 8; ++i) bb[i] = frag_l(sV, 72, 16 * (8 * vh + i), 32 * ks, lane);
                SCHED_BAR();
#pragma unroll
                for (int i = 0; i < 8; ++i) o[i] = MFMA16(bb[i], cAtt[ks], o[i]);
                SCHED_BAR(); }
#pragma unroll
            for (int ks = 0; ks < 4; ++ks) { bf16x8 bb[8];
#pragma unroll
                for (int i = 0; i < 8; ++i) bb[i] = frag_l(sS, 136, 16 * (8 * vh + i), 32 * ks, lane);
                SCHED_BAR();
#pragma unroll
                for (int i = 0; i < 8; ++i) o[i] = MFMA16(bb[i], cQ[ks], o[i]);
                SCHED_BAR(); }
            f32x4 acc[16];
            if (j + 1 < GC) { E::gather(acc, sS, w, lane); E::update(acc, sV, sKe, dec, w, lane); }
            __syncthreads();
            if (j + 1 < GC) E::to_lds(acc, sS, w, lane); else if (nhave) E::fill_state_dma(sS, nSB, nzero, tid, w, lane);
            o_to_lds(o, sO, mt, vh, lane);
            if (j + 1 < GC) { GLA_PTRS(j + 1) E::load_vk(pfV, pfK, VT_, KE_, tid); (void)ATT_; (void)row0_; }
            __syncthreads();
#pragma unroll
            for (int i = 0; i < 4; ++i) { const int id = tid + NTHREADS * i, row = id >> 5, c8 = (id & 31) * 8;
                const u32x4 ov = *(const LAS u32x4*)((const LAS bf16_t*)sO + row * 264 + c8);
                bf16_t* dst = Mix + (size_t)(row0 + row) * DMIX + h * 256 + c8;
                if (dir == 0) { *(u32x4*)dst = ov; }
                else { float x[8], p8[8], g8[8]; unpack8(ov, x); unpack8(part[i], p8); unpack8(gate[i], g8); float ss = 0.f;
#pragma unroll
                    for (int e = 0; e < 8; ++e) { x[e] += p8[e]; ss += x[e] * x[e]; }
                    const float rs = 1.f / sqrtf(half_wave_sum(ss) * (1.f / 256.f) + LN_EPS);
                    const f32x4 n0 = *(const f32x4*)(F.in[11] + c8), n1 = *(const f32x4*)(F.in[11] + c8 + 4);
#pragma unroll
                    for (int e = 0; e < 8; ++e) x[e] = x[e] * rs * (e < 4 ? n0[e & 3] : n1[e & 3]) * siluf_(g8[e]);
                    u32x4 pk; pk[0] = pk2(x[0], x[1]); pk[1] = pk2(x[2], x[3]); pk[2] = pk2(x[4], x[5]); pk[3] = pk2(x[6], x[7]);
                    *(u32x4*)dst = pk; } }
        }
#undef GLA_PTRS
#undef GLA_LOAD_A
    }
}
__device__ __forceinline__ void phase_out0(const Frame& F) {
    constexpr int NUO = BATCH * NGRP * 4;
#if defined(TEST_GLA_ONLY)
    for (int u = F.bid; u < NUO; u += F.G) gla_out_unit(F, u);
#elif defined(TEST_LRU_ONLY)
    ;
#else
    { bool have = false; for (int u = F.bid; u < NUO; u += F.G) { const int un = (u + F.G < NUO) ? u + F.G : -1; gla_out_unit(F, u, un, have); have = un >= 0; } }
    __syncthreads();
    { const bf16_t* P = PAP(bf16_t, PA_P); bf16_t* Mix = WSP(bf16_t, WS_ACT);
      const bf16_t* HL = PAP(bf16_t, PA0_HL); const bf16_t* ACF = PAP(bf16_t, PA0_ACF); const bf16_t* ACB = PAP(bf16_t, PA0_ACB); const float* HIN = PAP(float, PA0_HIN);
      for (size_t idx = (size_t)F.bid * NTHREADS + F.tid; idx < (size_t)T * 128; idx += (size_t)F.G * NTHREADS) {
          const int row = (int)(idx >> 7), ch0 = (int)(idx & 127) * 8;
          int b, c; if (row < TL) { b = row / SEQ; c = NCH_C + (row % SEQ) / 64; } else { b = (row - TL) / CTX; c = ((row - TL) % CTX) / 64; }
          const size_t o = (size_t)row * 1024 + ch0;
          const bf16x8 hl = *(const bf16x8*)(HL + o), af = *(const bf16x8*)(ACF + o), ab = *(const bf16x8*)(ACB + o), xg = *(const bf16x8*)(P + (size_t)row * NP0 + 4096 + ch0);
          const float* hf = HIN + (((size_t)0 * BATCH + b) * NCH + c) * 1024 + ch0; const float* hb = HIN + (((size_t)1 * BATCH + b) * NCH + c) * 1024 + ch0;
          const f32x4 hf0 = *(const f32x4*)hf, hf1 = *(const f32x4*)(hf + 4), hb0 = *(const f32x4*)hb, hb1 = *(const f32x4*)(hb + 4);
          float y[8];
#pragma unroll
          for (int e = 0; e < 8; ++e) { const float hh = bf2f((bf16_t)hl[e]) + bf2f((bf16_t)af[e]) * (e < 4 ? hf0[e & 3] : hf1[e & 3]) + bf2f((bf16_t)ab[e]) * (e < 4 ? hb0[e & 3] : hb1[e & 3]); y[e] = hh * gelu_tanhf_(bf2f((bf16_t)xg[e])); }
          u32x4 pk; pk[0] = pk2(y[0], y[1]); pk[1] = pk2(y[2], y[3]); pk[2] = pk2(y[4], y[5]); pk[3] = pk2(y[6], y[7]);
          *(u32x4*)(Mix + (size_t)row * DMIX + 1024 + ch0) = pk; } }
    __syncthreads();
    moe_weight_cvt(F, 0, (unsigned*)(F.ws + WS_CTL) + 16);
#endif
}

struct LnCfg { int l, which, nrows, porder, router; };
__device__ __forceinline__ void phase_ln(const Frame& F, const LnCfg cfg) {
    const int l = cfg.l, tid = F.tid, lane = F.lane, w = F.wave;
    const float* MODS = WSP(float, WS_MODS) + (size_t)l * 3 * 6 * D;
    const float* lng = F.in[6] + ((size_t)l * 2 + cfg.which) * D; const float* lnb = F.in[7] + ((size_t)l * 2 + cfg.which) * D;
    bf16_t* ACT = WSP(bf16_t, WS_ACT);
    bf16_t* sU2 = (bf16_t*)F.lds;
    float* sPart = (float*)(F.lds + 16 * (D + 8) * 2);
    float* sLog = sPart + 8 * 16 * 48;
    int* sCnt = (int*)(F.lds + 131072);
    if (tid < 32) sCnt[tid] = 0;
    __syncthreads();
    const int NG = cfg.nrows / 16, g0 = (int)((long)F.bid * NG / F.G), g1 = (int)((long)(F.bid + 1) * NG / F.G);
    const bf16_t* Ymix = PAP(bf16_t, PA_YMIX); const bf16_t* Y = PAP(bf16_t, PA_Y); const int* TOKSLOT = WSP(int, WS_TOKSLOT);
    const float* MODS_N = WSP(float, WS_MODS) + (size_t)3 * 6 * D;
    constexpr int NV = D / 256;
    DSUB_DECL;
    for (int g = g0; g < g1; ++g) {
        const int rowA = 16 * g + 2 * w;
        const int mr = rowA < TL ? rowA / SEQ : 2;
        const float* mg = MODS + (size_t)mr * 6 * D + (cfg.which ? 5 : 2) * D;
        const float* xin[2]; float* xout[2]; bf16_t* xb[2]; int sl0[2] = {0, 0}, sl1[2] = {0, 0}; float tg0[2] = {0.f, 0.f}, tg1[2] = {0.f, 0.f};
#pragma unroll
        for (int r = 0; r < 2; ++r) { const int row = rowA + r; xb[r] = PAP(bf16_t, PA_XB) + (size_t)row * D;
            if (row < TL) { const int xrow = cfg.porder ? raster_of_p(row) : row; xin[r] = (l == 0 && cfg.which == 0) ? F.in[0] + (size_t)xrow * D : F.out + (size_t)xrow * D; xout[r] = F.out + (size_t)xrow * D; }
            else { xin[r] = (cfg.which == 0) ? F.in[2] + (size_t)(row - TL) * D : WSP(float, WS_XC) + (size_t)(row - TL) * D; xout[r] = WSP(float, WS_XC) + (size_t)(row - TL) * D; }
            if (cfg.which) { sl0[r] = TOKSLOT[2 * row]; sl1[r] = TOKSLOT[2 * row + 1]; tg0[r] = WSP(float, WS_TOKG)[2 * row]; tg1[r] = WSP(float, WS_TOKG)[2 * row + 1]; } }
        float z[2][NV][4]; float s1[2] = {0.f, 0.f};
#pragma unroll
        for (int i = 0; i < NV; ++i) { const int col = i * 256 + lane * 4; const f32x4 gt = *(const f32x4*)(mg + col);
#pragma unroll
            for (int r = 0; r < 2; ++r) { const int row = rowA + r;
                f32x4 x;
                x = *(const f32x4*)(xin[r] + col);
                float y[4];
                if (cfg.which == 0) { const bf16x4 yv = *(const bf16x4*)(Ymix + (size_t)row * D + col);
#pragma unroll
                    for (int e = 0; e < 4; ++e) y[e] = bf2f((bf16_t)yv[e]); }
                else { const bf16x4 ya = *(const bf16x4*)(Y + (size_t)sl0[r] * D + col), yb = *(const bf16x4*)(Y + (size_t)sl1[r] * D + col);
#pragma unroll
                    for (int e = 0; e < 4; ++e) y[e] = tg0[r] * bf2f((bf16_t)ya[e]) + tg1[r] * bf2f((bf16_t)yb[e]); }
#pragma unroll
                for (int e = 0; e < 4; ++e) { z[r][i][e] = ALPHA * x[e] + gt[e] * y[e]; s1[r] += z[r][i][e]; } } }
#pragma unroll
        for (int m = 32; m >= 1; m >>= 1) { s1[0] += __shfl_xor(s1[0], m); s1[1] += __shfl_xor(s1[1], m); }
        const float mu[2] = {s1[0] * (1.f / D), s1[1] * (1.f / D)};
        float s2[2] = {0.f, 0.f};
#pragma unroll
        for (int r = 0; r < 2; ++r)
#pragma unroll
            for (int i = 0; i < NV; ++i)
#pragma unroll
                for (int e = 0; e < 4; ++e) { const float dlt = z[r][i][e] - mu[r]; s2[r] += dlt * dlt; }
#pragma unroll
        for (int m = 32; m >= 1; m >>= 1) { s2[0] += __shfl_xor(s2[0], m); s2[1] += __shfl_xor(s2[1], m); }
        const float rstd[2] = {1.f / sqrtf(s2[0] * (1.f / D) + LN_EPS), 1.f / sqrtf(s2[1] * (1.f / D) + LN_EPS)};
#pragma unroll
        for (int i = 0; i < NV; ++i) { const int col = i * 256 + lane * 4; const f32x4 gg = *(const f32x4*)(lng + col), bb = *(const f32x4*)(lnb + col);
            f32x4 sh, sc;
            if (cfg.which == 0) { sh = *(const f32x4*)(MODS + (size_t)mr * 6 * D + 3 * D + col); sc = *(const f32x4*)(MODS + (size_t)mr * 6 * D + 4 * D + col); }
            else if (l == 0) { sh = *(const f32x4*)(MODS_N + (size_t)mr * 6 * D + col); sc = *(const f32x4*)(MODS_N + (size_t)mr * 6 * D + D + col); }
#pragma unroll
            for (int r = 0; r < 2; ++r) { const int row = rowA + r;
                f32x4 xo;
#pragma unroll
                for (int e = 0; e < 4; ++e) xo[e] = (z[r][i][e] - mu[r]) * rstd[r] * gg[e] + bb[e];
                if (cfg.which == 0) { *(f32x4*)(xout[r] + col) = xo;
                    u32x2 pk; pk[0] = pk2(xo[0] * (1.f + sc[0]) + sh[0], xo[1] * (1.f + sc[1]) + sh[1]); pk[1] = pk2(xo[2] * (1.f + sc[2]) + sh[2], xo[3] * (1.f + sc[3]) + sh[3]);
                    *(u32x2*)(ACT + (size_t)row * D + col) = pk; }
                else { if (xout[r]) *(f32x4*)(xout[r] + col) = xo;
                    if (l == 0) { int urow = row; if (row < TL) { const int bq = row / SEQ, s_ = row % SEQ, r_ = s_ / GRIDW, w_ = s_ % GRIDW; urow = bq * SEQ + w_ * GROWS + r_; }
                        u32x2 pk; pk[0] = pk2(xo[0] * (1.f + sc[0]) + sh[0], xo[1] * (1.f + sc[1]) + sh[1]); pk[1] = pk2(xo[2] * (1.f + sc[2]) + sh[2], xo[3] * (1.f + sc[3]) + sh[3]);
                        *(u32x2*)(ACT + (size_t)urow * D + col) = pk; } } } }
    }
    if (cfg.router) {
#ifndef CPU_EMU
        asm volatile("s_waitcnt vmcnt(0)" ::: "memory");
#endif
        __syncthreads();
        constexpr int KW = D / 8, NKS = KW / 32;
        const bf16_t* WR = WSP(bf16_t, WS_WR) + (size_t)l * 48 * D;
        bf16x8 bw[3][NKS];
#pragma unroll
        for (int nt_ = 0; nt_ < 3; ++nt_)
#pragma unroll
            for (int ks = 0; ks < NKS; ++ks) bw[nt_][ks] = frag(WR, D, 16 * nt_, w * KW + 32 * ks, lane);
        float* sPt = (float*)F.lds;
        float* sLg = sPt + 8 * 3 * 16 * 48;
        const int nmt = g1 - g0;
        for (int m0 = 0; m0 < nmt; m0 += 3) {
            const int nm = (nmt - m0) < 3 ? (nmt - m0) : 3;
            for (int mi = 0; mi < nm; ++mi) { const int rowb = 16 * (g0 + m0 + mi);
                bf16x8 a[NKS];
#pragma unroll
                for (int ks = 0; ks < NKS; ++ks) a[ks] = frag(ACT + (size_t)rowb * D, D, 0, w * KW + 32 * ks, lane);
                f32x4 acc[3] = {fzero4(), fzero4(), fzero4()};
#pragma unroll
                for (int ks = 0; ks < NKS; ++ks)
#pragma unroll
                    for (int nt_ = 0; nt_ < 3; ++nt_) acc[nt_] = MFMA16(a[ks], bw[nt_][ks], acc[nt_]);
#pragma unroll
                for (int nt_ = 0; nt_ < 3; ++nt_)
#pragma unroll
                    for (int j = 0; j < 4; ++j) sPt[((w * 3 + mi) * 16 + 4 * (lane >> 4) + j) * 48 + 16 * nt_ + (lane & 15)] = acc[nt_][j]; }
            __syncthreads();
            for (int i = tid; i < nm * 16 * 48; i += NTHREADS) { const int col = i % 48; float sm = 0.f;
#pragma unroll
                for (int q = 0; q < 8; ++q) sm += sPt[q * 3 * 16 * 48 + i];
                if (col < 4) sm += F.in[25][l * 4 + col]; else if (col < 36) sm += F.in[27][l * 32 + col - 4];
                sLg[i] = sm; }
            __syncthreads();
            if (tid < nm * 16) { const float* lg = sLg + tid * 48; const int row = 16 * (g0 + m0) + tid;
                int gi = 0; float gm = lg[0];
#pragma unroll
                for (int q = 1; q < 4; ++q) if (lg[q] > gm) { gm = lg[q]; gi = q; }
                float gs = 0.f;
#pragma unroll
                for (int q = 0; q < 4; ++q) gs += fexp(lg[q] - gm);
                const float pg = 1.f / gs;
                const float* el = lg + 4 + gi * 8;
                int i0 = 0; float mx0 = el[0];
#pragma unroll
                for (int q = 1; q < 8; ++q) if (el[q] > mx0) { mx0 = el[q]; i0 = q; }
                int i1 = -1; float mx1 = -3.0e38f;
#pragma unroll
                for (int q = 0; q < 8; ++q) if (q != i0 && el[q] > mx1) { mx1 = el[q]; i1 = q; }
                const float p1 = fexp(mx1 - mx0);
                const float g0_ = pg / (1.f + p1), g1_ = pg * p1 / (1.f + p1);
                const int e0 = gi * 8 + i0, e1 = gi * 8 + i1;
                WSP(int, WS_TOKE)[2 * row] = e0; WSP(int, WS_TOKE)[2 * row + 1] = e1; WSP(float, WS_TOKG)[2 * row] = g0_; WSP(float, WS_TOKG)[2 * row + 1] = g1_;
                atomicAdd(&sCnt[e0], 1); atomicAdd(&sCnt[e1], 1); }
            __syncthreads();
        }
        if (tid < 32) WSP(int, WS_WGCNT)[((size_t)l * 1024 + F.bid) * 32 + tid] = sCnt[tid];
    }
}

__device__ __forceinline__ void phase_slots(const Frame& F, int l, int nrows) {
    int* sTot = (int*)F.lds; int* sBefore = sTot + 32; int* sStart = sTot + 64; int* sCur = sTot + 96;
    const int tid = F.tid; const int* WGCNT = WSP(int, WS_WGCNT) + (size_t)l * 1024 * 32;
    { int* sPT = sTot + 128; int* sPB = sPT + 512;
      const int e = tid & 31, part = tid >> 5; int tot = 0, bef = 0;
#pragma unroll 4
      for (int wg = part; wg < F.G; wg += 16) { const int c = WGCNT[wg * 32 + e]; if (wg < F.bid) bef += c; tot += c; }
      sPT[tid] = tot; sPB[tid] = bef; }
    __syncthreads();
    if (tid < 32) { int tot = 0, bef = 0;
#pragma unroll
        for (int q = 0; q < 16; ++q) { tot += sTot[128 + q * 32 + tid]; bef += sTot[640 + q * 32 + tid]; }
        sTot[tid] = tot; sBefore[tid] = bef; sCur[tid] = 0; }
    __syncthreads();
    if (tid == 0) { int start = 0, tile = 0; int* TE = WSP(int, WS_TILEE);
        for (int e = 0; e < NEXP; ++e) { sStart[e] = start; const int nte = (sTot[e] + 255) / 256; if (F.bid == 0) for (int i = 0; i < nte; ++i) TE[64 + tile + i] = e; tile += nte; start += nte * 256; }
        if (F.bid == 0) TE[0] = tile; }
    __syncthreads();
    int* SLOT_TOK = WSP(int, WS_SLOTTOK); float* SLOT_GATE = WSP(float, WS_SLOTGATE); int* TOKSLOT = WSP(int, WS_TOKSLOT);
    for (int e = F.bid; e < NEXP; e += F.G) { const int lo = sStart[e] + sTot[e], hi = sStart[e] + ((sTot[e] + 255) / 256) * 256; for (int s = lo + tid; s < hi; s += NTHREADS) { SLOT_TOK[s] = 0; SLOT_GATE[s] = 0.f; } }
    const int NG = nrows / 16, r0 = 16 * (int)((long)F.bid * NG / F.G), r1 = 16 * (int)((long)(F.bid + 1) * NG / F.G);
    const int* TOKE = WSP(int, WS_TOKE); const float* TOKG = WSP(float, WS_TOKG);
    for (int idx = tid; idx < (r1 - r0) * 2; idx += NTHREADS) { const int row = r0 + (idx >> 1), k = idx & 1; const int e = TOKE[2 * row + k]; const int pos = atomicAdd(&sCur[e], 1);
        const int slot = sStart[e] + sBefore[e] + pos; SLOT_TOK[slot] = row; SLOT_GATE[slot] = TOKG[2 * row + k]; TOKSLOT[2 * row + k] = slot; }
}

struct MlIn { u32x4 q[2], k[2], v[4]; float g; };
__device__ __forceinline__ void ml_in_load(const Frame& F, int um, MlIn& in) {
    const int h = um & 7, bc = um >> 3, b = bc / NCH, c = bc % NCH, row0 = chunk_row0(b, c);
    const bf16_t* P = PAP(bf16_t, PA_P); const float* Gt = WSP(float, WS_G); const int tid = threadIdx.x;
#pragma unroll
    for (int i = 0; i < 2; ++i) { const int idx = tid + NTHREADS * i, t = idx >> 4, d0 = (idx & 15) * 8;
        in.q[i] = *(const u32x4*)(P + (size_t)(row0 + t) * NP1 + h * 128 + d0); in.k[i] = *(const u32x4*)(P + (size_t)(row0 + t) * NP1 + 1024 + h * 128 + d0); }
#pragma unroll
    for (int i = 0; i < 4; ++i) { const int idx = tid + NTHREADS * i, s_ = idx >> 5, vc = idx & 31; in.v[i] = *(const u32x4*)(P + (size_t)(row0 + s_) * NP1 + 2048 + h * 256 + vc * 8); }
    if (tid < 256) { const int t = tid >> 2, q = tid & 3; in.g = Gt[(size_t)(row0 + t) * 32 + q * 8 + h] + F.in[21][q * 8 + h]; }
    else { const int idx = tid - 256, dir = idx >> 7, t = (idx >> 1) & 63, which = idx & 1; const int pos = scan_chunk(dir, c);
        float v = 0.f; if (pos > 0) { const int rp = chunk_row0(b, scan_chunk(dir, pos - 1)); v = Gt[(size_t)(rp + t) * 32 + (2 * dir + which) * 8 + h] + F.in[21][(2 * dir + which) * 8 + h]; }
        in.g = v; }
}
__device__ __forceinline__ void ml_prep_unit(const Frame& F, int um, int um_next, MlIn& in) {
    const int h = um & 7, bc = um >> 3, b = bc / NCH, c = bc % NCH, row0 = chunk_row0(b, c);
    bf16_t* sQ = (bf16_t*)(F.lds + 0);
    bf16_t* sK = (bf16_t*)(F.lds + 17408);
    bf16_t* sV = (bf16_t*)(F.lds + 34816);
    float* sGt = (float*)(F.lds + 68608);
    float* sGpv = (float*)(F.lds + 69632);
    float* sB = (float*)(F.lds + 70656);
    float* sAa = sB + 128;
    float* sPm = sAa + 128;
    float* sSc = sPm + 128;
    const int tid = F.tid, lane = F.lane, w = F.wave;
#pragma unroll
    for (int i = 0; i < 2; ++i) { const int idx = tid + NTHREADS * i, t = idx >> 4, d0 = (idx & 15) * 8; *(u32x4*)(sQ + t * 136 + d0) = in.q[i]; *(u32x4*)(sK + t * 136 + d0) = in.k[i]; }
#pragma unroll
    for (int i = 0; i < 4; ++i) { const int idx = tid + NTHREADS * i, s_ = idx >> 5, vc = idx & 31; *(u32x4*)(sV + s_ * 264 + vc * 8) = in.v[i]; }
    if (tid < 256) sGt[tid] = in.g; else sGpv[tid - 256] = in.g;
    if (um_next >= 0) ml_in_load(F, um_next, in);
    __syncthreads();
    f32x4 qk[2];
    { const int mt = w & 3, nt0 = (w >> 2) * 2;
#pragma unroll
      for (int nn = 0; nn < 2; ++nn) { f32x4 acc = fzero4();
#pragma unroll
          for (int ks = 0; ks < 4; ++ks) acc = MFMA16(frag_l(sK, 136, 16 * (nt0 + nn), 32 * ks, lane), frag_l(sQ, 136, 16 * mt, 32 * ks, lane), acc);
          qk[nn] = acc; } }
    if (w < 4) { const int dir = w & 1, prev = w >> 1, t = dir ? 63 - lane : lane;
        const float ig = prev ? sGpv[(dir * 64 + t) * 2] : sGt[t * 4 + 2 * dir], fl = log_sigmoidf_(prev ? sGpv[(dir * 64 + t) * 2 + 1] : sGt[t * 4 + 2 * dir + 1]);
        float run = fl;
#pragma unroll
        for (int k = 1; k < 64; k <<= 1) { const float o = __shfl(run, lane - k); if (lane >= k) run += o; }
        const float a = ig - run; float pm = a;
#pragma unroll
        for (int k = 1; k < 64; k <<= 1) { const float o = __shfl(pm, lane - k); if (lane >= k) pm = fmaxf(pm, o); }
        if (!prev) { sB[dir * 64 + t] = run; sAa[dir * 64 + t] = a; sPm[dir * 64 + t] = pm; if (lane == 63) sSc[2 + dir] = pm; }
        else if (lane == 63) sSc[dir] = (scan_chunk(dir, c) > 0) ? run + pm : -1.0e30f; }
    __syncthreads();
#pragma unroll
    for (int dir = 0; dir < 2; ++dir) { const float mu = sSc[dir], Pall = sSc[2 + dir];
        { const int mt = w & 3, nt0 = (w >> 2) * 2; bf16_t* SM = PAP(bf16_t, PA1_SM) + ((size_t)um * 2 + dir) * 4096;
          const int t = 16 * mt + (lane & 15); const float Mt = fmaxf(mu, sPm[dir * 64 + t]);
#pragma unroll
          for (int nn = 0; nn < 2; ++nn) { const int s0 = 16 * (nt0 + nn) + 4 * (lane >> 4); float m4[4];
#pragma unroll
              for (int j = 0; j < 4; ++j) { const int s_ = s0 + j; const bool keep = dir == 0 ? (s_ <= t) : (s_ >= t); m4[j] = keep ? qk[nn][j] * fexp(sAa[dir * 64 + s_] - Mt) : 0.f; }
              u32x2 pk; pk[0] = pk2(m4[0], m4[1]); pk[1] = pk2(m4[2], m4[3]); *(u32x2*)(SM + t * 64 + s0) = pk; } }
        if (tid < 64) { const float Mt = fmaxf(mu, sPm[dir * 64 + tid]); float* WF = PAP(float, PA1_WF) + ((size_t)um * 2 + dir) * 128; WF[tid] = fexp(mu - Mt); WF[64 + tid] = fexp(-(sB[dir * 64 + tid] + Mt)); }
        if (tid == 64) PAP(float, PA1_DEC)[(size_t)um * 2 + dir] = fexp(mu - Pall);
        { bf16_t* KEW = PAP(bf16_t, PA1_KEW) + ((size_t)um * 2 + dir) * 128 * 64;
#pragma unroll
          for (int i = 0; i < 2; ++i) { const int idx = tid + NTHREADS * i, d = idx >> 3, sc = idx & 7; float x[8];
#pragma unroll
              for (int e = 0; e < 8; ++e) x[e] = bf2f(sK[(sc * 8 + e) * 136 + d]) * fexp(sAa[dir * 64 + sc * 8 + e] - Pall);
              u32x4 pk; pk[0] = pk2(x[0], x[1]); pk[1] = pk2(x[2], x[3]); pk[2] = pk2(x[4], x[5]); pk[3] = pk2(x[6], x[7]);
              *(u32x4*)(KEW + d * 64 + sc * 8) = pk; } } }
    { bf16_t* VT = PAP(bf16_t, PA1_VT) + (size_t)um * MLV * 64;
#pragma unroll
      for (int i = 0; i < 4; ++i) { const int idx = tid + NTHREADS * i, v = idx >> 3, sc = idx & 7; bf16x8 o;
#pragma unroll
          for (int e = 0; e < 8; ++e) o[e] = (short)sV[(sc * 8 + e) * 264 + v];
          *(bf16x8*)(VT + v * 64 + sc * 8) = o; }
      if (tid < 128) { const unsigned one2 = (tid >> 3) == 0 ? 0x3F803F80u : 0u; u32x4 o = {one2, one2, one2, one2}; *(u32x4*)(VT + (256 + (tid >> 3)) * 64 + (tid & 7) * 8) = o; } }
    __syncthreads();
}
__device__ __forceinline__ void phase_prep1(const Frame& F) { MlIn in; if (F.bid < NU_ML) ml_in_load(F, F.bid, in); for (int u = F.bid; u < NU_ML; u += F.G) ml_prep_unit(F, u, (u + F.G < NU_ML) ? u + F.G : -1, in); }

__device__ __forceinline__ void phase_agg1(const Frame& F) {
    typedef Eng<17> E;
    const int tid = F.tid, lane = F.lane, w = F.wave;
    bf16_t* sS = (bf16_t*)(F.lds + E::OFF_S); bf16_t* sV = (bf16_t*)(F.lds + E::OFF_V); bf16_t* sKe = (bf16_t*)(F.lds + E::OFF_K);
    constexpr int NUA = BATCH * NGRP * 16;
    u32x4 pfV[E::NPV], pfK[2]; float decn;
#define AGG1_LOAD(uu, jj) do { const int h_ = (uu) & 7, dir_ = ((uu) >> 3) & 1, bg_ = (uu) >> 4, b_ = bg_ / NGRP, g_ = bg_ % NGRP; const int um_ = (b_ * NCH + group_chunk(g_, dir_, (jj))) * 8 + h_; \
        E::load_vk(pfV, pfK, PAP(bf16_t, PA1_VT) + (size_t)um_ * MLV * 64, PAP(bf16_t, PA1_KEW) + ((size_t)um_ * 2 + dir_) * 128 * 64, tid); decn = PAP(float, PA1_DEC)[(size_t)um_ * 2 + dir_]; } while (0)
    if (F.bid < NUA) AGG1_LOAD(F.bid, 0);
    for (int u = F.bid; u < NUA; u += F.G) {
        const int h = u & 7, dir = (u >> 3) & 1, bg = u >> 4, b = bg / NGRP, g = bg % NGRP, scan = (b * 8 + h) * 2 + dir;
        f32x4 acc[17];
#pragma unroll
        for (int vt = 0; vt < 17; ++vt) acc[vt] = fzero4();
        float Dg = 1.f;
        for (int j = 0; j < GC; ++j) {
            __syncthreads();
            E::stage_vk(pfV, pfK, sV, sKe, tid);
            const float dec = decn;
            __syncthreads();
            if (j + 1 < GC) AGG1_LOAD(u, j + 1); else if (u + F.G < NUA) AGG1_LOAD(u + F.G, 0);
            E::update(acc, sV, sKe, dec, w, lane);
            Dg *= dec; }
        MFMA_DRAIN();
        E::to_lds(acc, sS, w, lane);
        if (tid == 0) PAP(float, PA1_DG)[(size_t)scan * NGRP + g] = Dg;
        __syncthreads();
        E::store_state(sS, PAP(bf16_t, PA1_KVG) + ((size_t)scan * NGRP + g) * (MLV * 128), tid);
    }
#undef AGG1_LOAD
}
__device__ __forceinline__ void phase_gscan1(const Frame& F) { group_scan<32, MLV * 128, false>(F, PAP(bf16_t, PA1_KVG), PAP(float, PA1_DG)); }

__device__ __forceinline__ void ml_out_unit(const Frame& F, int u, int u_next, bool have_state) {
    typedef Eng<17> E;
    const int h = u & 7, bg = u >> 3, b = bg / NGL, g = NGC + bg % NGL;
    int tz0 = threadIdx.x; OPAQUE(tz0);
    const int tid = tz0, lane = tz0 & 63, w = RFL(tz0 >> 6), mt = w & 3, vh = w >> 2;
    bf16_t* sS = (bf16_t*)(F.lds + E::OFF_S); bf16_t* sV = (bf16_t*)(F.lds + E::OFF_V); bf16_t* sKe = (bf16_t*)(F.lds + E::OFF_K);
    bf16_t* sO = sV;
    float* sDen = (float*)(F.lds + E::OFF_X);
    const bf16_t* P = PAP(bf16_t, PA_P); bf16_t* Mix = WSP(bf16_t, WS_ACT);
    const int tq = 16 * mt + 4 * (lane >> 4); (void)tq;
    DSUB_DECL;
    DSUB_BEGIN(7);
#pragma unroll 1
    for (int dir = 0; dir < 2; ++dir) {
        const int scan = (b * 8 + h) * 2 + dir; const bool first = (g == scan_group(dir, 0));
        DSUB_BEGIN(1);
        u32x4 pfV[E::NPV], pfK[2]; bf16x8 aSm[2], aQ[4]; float win, fln, decn;
#define ML_PTRS(jx) const int c_ = group_chunk(g, dir, (jx)), um_ = (b * NCH + c_) * 8 + h, row0_ = chunk_row0(b, c_); \
        const bf16_t* VT_ = PAP(bf16_t, PA1_VT) + (size_t)um_ * MLV * 64; const bf16_t* KE_ = PAP(bf16_t, PA1_KEW) + ((size_t)um_ * 2 + dir) * 128 * 64;
#define ML_LOAD_A() do { const bf16_t* SM_ = PAP(bf16_t, PA1_SM) + ((size_t)um_ * 2 + dir) * 4096; \
        _Pragma("unroll") for (int ks = 0; ks < 2; ++ks) aSm[ks] = frag(SM_, 64, 16 * mt, 32 * ks, lane); \
        _Pragma("unroll") for (int ks = 0; ks < 4; ++ks) aQ[ks] = frag(P + (size_t)row0_ * NP1 + h * 128, NP1, 16 * mt, 32 * ks, lane); \
        win = PAP(float, PA1_WF)[((size_t)um_ * 2 + dir) * 128 + 16 * mt + (lane & 15)]; fln = PAP(float, PA1_WF)[((size_t)um_ * 2 + dir) * 128 + 64 + 16 * mt + (lane & 15)]; decn = PAP(float, PA1_DEC)[(size_t)um_ * 2 + dir]; } while (0)
        { ML_PTRS(0) E::load_vk(pfV, pfK, VT_, KE_, tid); (void)row0_; }
        if (dir == 0 && !have_state) { __syncthreads(); E::fill_state(sS, PAP(bf16_t, PA1_KVG) + ((size_t)scan * NGRP + g) * (MLV * 128), first, tid); }
        else {
#ifndef CPU_EMU
            asm volatile("s_waitcnt vmcnt(0)" ::: "memory");
#endif
        }
        const bf16_t* nSB = nullptr; bool nzero = false, nhave = false;
        if (dir == 0) { nSB = PAP(bf16_t, PA1_KVG) + ((size_t)(scan + 1) * NGRP + g) * (MLV * 128); nzero = (g == scan_group(1, 0)); nhave = true; }
        else if (u_next >= 0) { const int h2 = u_next & 7, bg2 = u_next >> 3, b2 = bg2 / NGL, g2 = NGC + bg2 % NGL; nSB = PAP(bf16_t, PA1_KVG) + ((size_t)((b2 * 8 + h2) * 2) * NGRP + g2) * (MLV * 128); nzero = (g2 == scan_group(0, 0)); nhave = true; }
        DSUB_END(1);
#pragma unroll 1
        for (int j = 0; j < GC; ++j) {
            const int c = group_chunk(g, dir, j), row0 = chunk_row0(b, c);
            int tz = threadIdx.x; OPAQUE(tz);
            const int tid = tz, lane = tz & 63, w = RFL(tz >> 6), mt = w & 3, vh = w >> 2, tq = 16 * mt + 4 * (lane >> 4);
            DSUB_BEGIN(2);
            { ML_PTRS(j) (void)VT_; (void)KE_; ML_LOAD_A(); }
            __syncthreads();
            E::stage_vk(pfV, pfK, sV, sKe, tid);
            bf16x8 cSm[2], cQ[4];
#pragma unroll
            for (int ks = 0; ks < 2; ++ks) cSm[ks] = aSm[ks];
#pragma unroll
            for (int ks = 0; ks < 4; ++ks) cQ[ks] = aQ[ks];
            const float dec = decn, wi = win, fl = fln;
            __syncthreads();
            DSUB_END(2);
            DSUB_BEGIN(3);
            f32x4 o[8], od = fzero4();
#pragma unroll
            for (int i = 0; i < 8; ++i) o[i] = fzero4();
#pragma unroll
            for (int ks = 0; ks < 4; ++ks) {
#pragma unroll
                for (int hb = 0; hb < 2; ++hb) { bf16x8 bb[4], bd;
#pragma unroll
                    for (int i = 0; i < 4; ++i) bb[i] = frag_l(sS, 136, 16 * (8 * vh + 4 * hb + i), 32 * ks, lane);
                    if (vh == 1 && hb == 1) bd = frag_l(sS, 136, 256, 32 * ks, lane);
                    SCHED_BAR();
#pragma unroll
                    for (int i = 0; i < 4; ++i) o[4 * hb + i] = MFMA16(bb[i], cQ[ks], o[4 * hb + i]);
                    if (vh == 1 && hb == 1) od = MFMA16(bd, cQ[ks], od);
                    SCHED_BAR(); } }
            od = od * wi;
#pragma unroll
            for (int i = 0; i < 8; ++i) o[i] = o[i] * wi;
#pragma unroll
            for (int ks = 0; ks < 2; ++ks) {
#pragma unroll
                for (int hb = 0; hb < 2; ++hb) { bf16x8 bb[4], bd;
#pragma unroll
                    for (int i = 0; i < 4; ++i) bb[i] = frag_l(sV, 72, 16 * (8 * vh + 4 * hb + i), 32 * ks, lane);
                    if (vh == 1 && hb == 1) bd = frag_l(sV, 72, 256, 32 * ks, lane);
                    SCHED_BAR();
#pragma unroll
                    for (int i = 0; i < 4; ++i) o[4 * hb + i] = MFMA16(bb[i], cSm[ks], o[4 * hb + i]);
                    if (vh == 1 && hb == 1) od = MFMA16(bd, cSm[ks], od);
                    SCHED_BAR(); } }
            DSUB_END(3);
            DSUB_BEGIN(4);
            f32x4 acc[17];
            if (j + 1 < GC) { E::gather(acc, sS, w, lane); E::update(acc, sV, sKe, dec, w, lane); }
            DSUB_END(4);
            DSUB_BEGIN(5);
            __syncthreads();
            if (j + 1 < GC) E::to_lds(acc, sS, w, lane);
            o_to_lds(o, sO, mt, vh, lane);
            if (j + 1 < GC) { ML_PTRS(j + 1) E::load_vk(pfV, pfK, VT_, KE_, tid); (void)row0_; }
            u32x4 part[4], gate[4];
            if (dir == 1) {
#pragma unroll
                for (int i = 0; i < 4; ++i) { const int id = tid + NTHREADS * i, row = id >> 5, c8 = (id & 31) * 8;
                    part[i] = *(const u32x4*)(Mix + (size_t)(row0 + row) * DMIX + h * 256 + c8); gate[i] = *(const u32x4*)(P + (size_t)(row0 + row) * NP1 + 4096 + h * 256 + c8); } }
            if (vh == 1 && lane < 16) ((LAS float*)sDen)[16 * mt + lane] = 1.f / fmaxf(fabsf(od[0]), fl);
            if (j + 1 == GC && nhave) E::fill_state_dma(sS, nSB, nzero, tid, w, lane);
            __syncthreads();
            DSUB_END(5);
            DSUB_BEGIN(6);
#pragma unroll
            for (int i = 0; i < 4; ++i) { const int id = tid + NTHREADS * i, row = id >> 5, c8 = (id & 31) * 8;
                const u32x4 ov = *(const LAS u32x4*)((const LAS bf16_t*)sO + row * 264 + c8);
                const float inv = ((const LAS float*)sDen)[row];
                bf16_t* dst = Mix + (size_t)(row0 + row) * DMIX + h * 256 + c8;
                float x[8]; unpack8(ov, x);
#pragma unroll
                for (int e = 0; e < 8; ++e) x[e] *= inv;
                if (dir == 1) { float p8[8], g8[8]; unpack8(part[i], p8); unpack8(gate[i], g8); float ss = 0.f;
#pragma unroll
                    for (int e = 0; e < 8; ++e) { x[e] += p8[e]; ss += x[e] * x[e]; }
                    const float rs = 1.f / sqrtf(half_wave_sum(ss) * (1.f / 256.f) + LN_EPS);
                    const f32x4 n0 = *(const f32x4*)(F.in[22] + c8), n1 = *(const f32x4*)(F.in[22] + c8 + 4);
#pragma unroll
                    for (int e = 0; e < 8; ++e) x[e] = x[e] * rs * (e < 4 ? n0[e & 3] : n1[e & 3]) * sigmoidf_(g8[e]); }
                u32x4 pk; pk[0] = pk2(x[0], x[1]); pk[1] = pk2(x[2], x[3]); pk[2] = pk2(x[4], x[5]); pk[3] = pk2(x[6], x[7]);
                *(u32x4*)dst = pk; }
            DSUB_END(6);
        }
#undef ML_PTRS
#undef ML_LOAD_A
    }
    DSUB_END(7);
}
__device__ __forceinline__ void phase_out1(const Frame& F) { bool have = false; for (int u = F.bid; u < BATCH * NGL * 8; u += F.G) { const int un = (u + F.G < BATCH * NGL * 8) ? u + F.G : -1; ml_out_unit(F, u, un, have); have = un >= 0; } }

constexpr int N_PHASES = 24;
constexpr int LDS_BYTES = 147456;
#ifdef CPU_EMU
#define GRID_BAR() do { } while (0)
#else
#define GRID_BAR() xcd_barrier(bar)
#endif

__global__ void __launch_bounds__(NTHREADS, 2) mk_fwd(Args args) {
#ifdef CPU_EMU
    unsigned char* lds = emu_blk->lds;
#else
    extern __shared__ __attribute__((aligned(16))) unsigned char lds_raw[];
    unsigned char* lds = (unsigned char*)lds_raw;
#endif
    Frame F; F.in = args.in; F.out = args.out; F.ws = args.ws; F.lds = lds;
    F.tid = threadIdx.x; F.lane = F.tid & 63; F.wave = RFL(F.tid >> 6); F.G = gridDim.x; F.bid = blockIdx.x;
#ifndef CPU_EMU
    LAS unsigned char* ldsl = (LAS unsigned char*)lds_raw;
    volatile LAS unsigned* bst = (volatile LAS unsigned*)(ldsl + LDS_BYTES - 16);
    if (F.tid == 0) { bst[0] = 0u; bst[1] = 0u; }
    __syncthreads();
    XcdBarrier bar = xcd_barrier_post((unsigned*)(args.ws + WS_CTL) + 1024, bst);
#endif
    const int lo = args.ph_lo, hi = args.ph_hi;
#if defined(DIAG_SUB) && !defined(CPU_EMU)
    if (F.tid == 0) *(volatile LAS unsigned long long*)(ldsl + LDS_BYTES - 32) = 0ull;
#endif
#ifdef ONLY_PH
#define IN(k) ((k) == ONLY_PH && lo <= (k) && (k) < hi)
#else
#define IN(k) (lo <= (k) && (k) < hi)
#endif
#define SEAM(k) do { if (IN(k) && IN((k) + 1)) GRID_BAR(); } while (0)
#ifdef CPU_EMU
#define GEMM_LDS lds
#else
#define GEMM_LDS ldsl
#endif
#ifdef DIAG_MASK
    unsigned long long dg_t0 = 0, dg_acc = 0;
#define DIAG0(k) do { if ((DIAG_MASK >> (k)) & 1) dg_t0 = wall_clock64(); } while (0)
#define DIAG1(k) do { if ((DIAG_MASK >> (k)) & 1) dg_acc += wall_clock64() - dg_t0; } while (0)
#else
#define DIAG0(k) do { } while (0)
#define DIAG1(k) do { } while (0)
#endif
    DIAG0(0); if (IN(0)) { phase_prologue(F); } SEAM(0); DIAG1(0);
    DIAG0(1); if (IN(1)) { phase_modulate0(F); } SEAM(1); DIAG1(1);
    DIAG0(2); if (IN(2)) { Gemm g{WSP(bf16_t, WS_ACT), WSP(bf16_t, WS_WIN0), D, nullptr}; StaticOrder S{T / 256, NW0 / 256, F.G, F.bid}; EpiIn E{PAP(bf16_t, PA_P), NP0, WSP(float, WS_G), NP0 / 256};
        gemm_phase(GEMM_LDS, g, S, E); } SEAM(2); DIAG1(2);
    DIAG0(3); if (IN(3)) { phase_prep0(F); } SEAM(3); DIAG1(3);
    DIAG0(4); if (IN(4)) { phase_agg0(F); } SEAM(4); DIAG1(4);
    DIAG0(5); if (IN(5)) { phase_gscan0(F); } SEAM(5); DIAG1(5);
    DIAG0(6); if (IN(6)) { phase_out0(F); } SEAM(6); DIAG1(6);
    DIAG0(7); if (IN(7)) { Gemm g{WSP(bf16_t, WS_ACT), WSP(bf16_t, WS_WOUT0), DMIX, nullptr}; StaticOrder S{T / 256, D / 256, F.G, F.bid}; EpiBf E{PAP(bf16_t, PA_YMIX), D};
        gemm_phase(GEMM_LDS, g, S, E); } SEAM(7); DIAG1(7);
    DIAG0(8); if (IN(8)) { phase_ln(F, LnCfg{0, 0, T, 0, 1}); } SEAM(8); DIAG1(8);
    DIAG0(9); if (IN(9)) { phase_slots(F, 0, T); } SEAM(9); DIAG1(9);
    DIAG0(10); if (IN(10)) { const int* TE = WSP(int, WS_TILEE); Gemm g{WSP(bf16_t, WS_ACT), WSP(bf16_t, WS_MOEW1), D, WSP(int, WS_SLOTTOK)}; MoeOrder S{TE + 64, TE[0], 4, F.G, F.bid}; EpiMoe1 E{PAP(bf16_t, PA_H)};
        gemm_phase(GEMM_LDS, g, S, E); } SEAM(10); DIAG1(10);
    DIAG0(11); if (IN(11)) { const int* TE = WSP(int, WS_TILEE); Gemm g{PAP(bf16_t, PA_H), WSP(bf16_t, WS_MOEW2), DEXP, nullptr}; MoeOrder S{TE + 64, TE[0], D / 256, F.G, F.bid}; EpiMoe2 E{PAP(bf16_t, PA_Y), WSP(float, WS_SLOTGATE), D / 256};
        gemm_phase(GEMM_LDS, g, S, E); } SEAM(11); DIAG1(11);
    DIAG0(12); if (IN(12)) { phase_ln(F, LnCfg{0, 1, T, 0, 0}); } SEAM(12); DIAG1(12);
    DIAG0(13); if (IN(13)) { Gemm g{WSP(bf16_t, WS_ACT), WSP(bf16_t, WS_WIN1), D, nullptr}; StaticOrder S{T / 256, NW1 / 256, F.G, F.bid}; EpiIn E{PAP(bf16_t, PA_P), NP1, WSP(float, WS_G), NP1 / 256};
        const bool cvt_first = ((F.bid >> 3) & 1) == 0;
        if (cvt_first) { moe_weight_cvt(F, 1); __syncthreads(); }
        gemm_phase(GEMM_LDS, g, S, E);
        if (!cvt_first) { __syncthreads(); moe_weight_cvt(F, 1); } } SEAM(13); DIAG1(13);
    DIAG0(14); if (IN(14)) { phase_prep1(F); } SEAM(14); DIAG1(14);
    DIAG0(15); if (IN(15)) { phase_agg1(F); } SEAM(15); DIAG1(15);
    DIAG0(16); if (IN(16)) { phase_gscan1(F); } SEAM(16); DIAG1(16);
    DIAG0(17); if (IN(17)) { phase_out1(F); } SEAM(17); DIAG1(17);
    DIAG0(18); if (IN(18)) { Gemm g{WSP(bf16_t, WS_ACT), WSP(bf16_t, WS_WOUT1), DMIX, nullptr}; StaticOrder S{TL / 256, D / 256, F.G, F.bid}; EpiBf E{PAP(bf16_t, PA_YMIX), D};
        gemm_phase(GEMM_LDS, g, S, E); } SEAM(18); DIAG1(18);
    DIAG0(19); if (IN(19)) { phase_ln(F, LnCfg{1, 0, TL, 1, 1}); } SEAM(19); DIAG1(19);
    DIAG0(20); if (IN(20)) { phase_slots(F, 1, TL); } SEAM(20); DIAG1(20);
    DIAG0(21); if (IN(21)) { const int* TE = WSP(int, WS_TILEE); Gemm g{WSP(bf16_t, WS_ACT), WSP(bf16_t, WS_MOEW1), D, WSP(int, WS_SLOTTOK)}; MoeOrder S{TE + 64, TE[0], 4, F.G, F.bid}; EpiMoe1 E{PAP(bf16_t, PA_H)};
        gemm_phase(GEMM_LDS, g, S, E); } SEAM(21); DIAG1(21);
    DIAG0(22); if (IN(22)) { const int* TE = WSP(int, WS_TILEE); Gemm g{PAP(bf16_t, PA_H), WSP(bf16_t, WS_MOEW2), DEXP, nullptr}; MoeOrder S{TE + 64, TE[0], D / 256, F.G, F.bid}; EpiMoe2 E{PAP(bf16_t, PA_Y), WSP(float, WS_SLOTGATE), D / 256};
        gemm_phase(GEMM_LDS, g, S, E); } SEAM(22); DIAG1(22);
    DIAG0(23); if (IN(23)) { phase_ln(F, LnCfg{1, 1, TL, 1, 0}); } DIAG1(23);
#if defined(DIAG_SUB) && !defined(CPU_EMU)
    if (blockIdx.x == 0 && F.tid == 0) { const unsigned long long te = wall_clock64(), want = *(volatile LAS unsigned long long*)(ldsl + LDS_BYTES - 32) * DIAG_MULT; while (wall_clock64() - te < want) __builtin_amdgcn_s_sleep(8); }
#endif
#ifdef DIAG_MASK
    if (blockIdx.x == 0) { const unsigned long long te = wall_clock64(), want = dg_acc * DIAG_MULT; while (wall_clock64() - te < want) __builtin_amdgcn_s_sleep(8); }
#endif
#undef IN
#undef SEAM
}

#ifndef MK_N_LAUNCHES
#define MK_N_LAUNCHES 1
#endif
extern "C" void kernel_launch(void* const* d_in, const int* in_sizes, int n_in, void* d_out, int out_size, void* d_ws, size_t ws_size, hipStream_t stream) {
    (void)in_sizes; (void)out_size;
    Args a{};
    for (int i = 0; i < 31 && i < n_in; ++i) a.in[i] = (const float*)d_in[i];
    a.out = (float*)d_out; a.ws = (unsigned char*)d_ws;
#ifdef CPU_EMU
    if (ws_size < WS_END) { fprintf(stderr, "ws too small: %zu < %zu\n", ws_size, (size_t)WS_END); return; }
    int grid = 32; const char* eg = getenv("EMU_GRID"); if (eg) grid = atoi(eg);
    int p0 = 0, p1 = N_PHASES; const char* e0 = getenv("EMU_PH0"); if (e0) p0 = atoi(e0); const char* e1 = getenv("EMU_PH1"); if (e1) p1 = atoi(e1);
    for (int ph = p0; ph < p1; ++ph) { a.ph_lo = ph; a.ph_hi = ph + 1; fprintf(stderr, "[emu] phase %d\n", ph); emu_launch(mk_fwd, grid, NTHREADS, LDS_BYTES, a); }
#else
    static int grid = 0;
    if (grid == 0) {
        if (n_in != 31 || ws_size < WS_END) { fprintf(stderr, "kernel_launch: n_in %d ws %zu (need %zu)\n", n_in, ws_size, (size_t)WS_END); grid = -1; return; }
        int dev = 0, cus = 0, per_cu = 0;
        hipGetDevice(&dev); hipDeviceGetAttribute(&cus, hipDeviceAttributeMultiprocessorCount, dev);
        if (hipFuncSetAttribute((const void*)mk_fwd, hipFuncAttributeMaxDynamicSharedMemorySize, LDS_BYTES) != hipSuccess) { fprintf(stderr, "kernel_launch: hipFuncSetAttribute failed\n"); grid = -1; return; }
        if (hipOccupancyMaxActiveBlocksPerMultiprocessor(&per_cu, (const void*)mk_fwd, NTHREADS, LDS_BYTES) != hipSuccess || per_cu < 1) { fprintf(stderr, "kernel_launch: occupancy query says %d\n", per_cu); }
        (void)hipGetLastError();
        grid = cus;
    }
    if (grid < 0) return;
    hipMemsetAsync((char*)d_ws + WS_CTL, 0, CTL_BYTES, stream);
    constexpr int NL = MK_N_LAUNCHES;
    for (int li = 0; li < NL; ++li) {
        a.ph_lo = (int)((long)li * N_PHASES / NL); a.ph_hi = (int)((long)(li + 1) * N_PHASES / NL);
        hipLaunchKernelGGL(mk_fwd, dim3(grid), dim3(NTHREADS), LDS_BYTES, stream, a);
    }
#endif
}
```

```cpp
#ifndef CPU_EMU
#include <hip/hip_runtime.h>
#include <cstdio>
#endif
#include <stdint.h>
#include <stddef.h>

#ifdef CPU_EMU_SMALL
constexpr int D = 256, SEQ = 512, CTX = 256, GRIDW = 8;
#else
constexpr int D = 2048, SEQ = 16384, CTX = 256, GRIDW = 64;
#endif
constexpr int BATCH = 2, GROWS = SEQ / GRIDW;
constexpr int TL = BATCH * SEQ, TC = BATCH * CTX, T = TL + TC;
constexpr int NCH_C = CTX / 64, NCH_L = SEQ / 64, NCH = NCH_C + NCH_L;
constexpr int NP0 = 5120, NW0 = 5376, NP1 = 6144, NW1 = 6400;
constexpr int DMIX = 2048;
constexpr int NEXP = 32, DEXP = 512;
constexpr float ALPHA = 1.41421356237f, LN_EPS = 1e-5f;
constexpr int NU_GLA = BATCH * NCH * 4, NU_LRU = BATCH * NCH * 8, NU_ML = BATCH * NCH * 8;
constexpr int NTILE_MAX = (2 * T + 255) / 256 + NEXP;
constexpr int NSLOT_MAX = NTILE_MAX * 256;
constexpr int NTHREADS = 512;
static_assert(T % 256 == 0 && TL % 256 == 0 && D % 256 == 0 && SEQ % 64 == 0 && CTX % 64 == 0, "tiling");

typedef unsigned short bf16_t;
typedef short bf16x8 __attribute__((ext_vector_type(8)));
typedef short bf16x4 __attribute__((ext_vector_type(4)));
typedef float f32x4 __attribute__((ext_vector_type(4)));
typedef float f32x2 __attribute__((ext_vector_type(2)));
typedef unsigned u32x4 __attribute__((ext_vector_type(4)));
typedef unsigned u32x2 __attribute__((ext_vector_type(2)));

constexpr size_t AL(size_t x) { return (x + 255) & ~(size_t)255; }
constexpr size_t WS_CTL = 0, CTL_BYTES = 1u << 20;
constexpr size_t WS_WGCNT = WS_CTL + CTL_BYTES;
constexpr size_t WS_MODS = WS_WGCNT + AL(2 * 1024 * 32 * 4);
constexpr size_t WS_TOKE = WS_MODS + AL((size_t)2 * 3 * 6 * D * 4);
constexpr size_t WS_TOKG = WS_TOKE + AL((size_t)T * 2 * 4);
constexpr size_t WS_TOKSLOT = WS_TOKG + AL((size_t)T * 2 * 4);
constexpr size_t WS_SLOTTOK = WS_TOKSLOT + AL((size_t)T * 2 * 4);
constexpr size_t WS_SLOTGATE = WS_SLOTTOK + AL((size_t)NSLOT_MAX * 4);
constexpr size_t WS_TILEE = WS_SLOTGATE + AL((size_t)NSLOT_MAX * 4);
constexpr size_t WS_WIN0 = WS_TILEE + AL((size_t)(NTILE_MAX + 64) * 4);
constexpr size_t WS_WIN1 = WS_WIN0 + AL((size_t)NW0 * D * 2);
constexpr size_t WS_WOUT0 = WS_WIN1 + AL((size_t)NW1 * D * 2);
constexpr size_t WS_WOUT1 = WS_WOUT0 + AL((size_t)D * DMIX * 2);
constexpr size_t WS_WLRU = WS_WOUT1 + AL((size_t)D * DMIX * 2);
constexpr size_t WS_WR = WS_WLRU + AL((size_t)32 * 128 * 128 * 2);
constexpr size_t WS_MOEW1 = WS_WR + AL((size_t)2 * 48 * D * 2);
constexpr size_t WS_MOEW2 = WS_MOEW1 + AL((size_t)NEXP * 1024 * D * 2);
constexpr size_t WS_ACT = WS_MOEW2 + AL((size_t)NEXP * D * DEXP * 2);
constexpr size_t WS_G = WS_ACT + AL((size_t)T * DMIX * 2);
constexpr size_t WS_XC = WS_G + AL((size_t)T * 32 * 4);
constexpr size_t WS_PA = WS_XC + AL((size_t)TC * D * 4);
constexpr size_t PA_P = 0;
constexpr size_t A0 = AL((size_t)T * NP0 * 2);
constexpr int GC = 4, NGC = NCH_C / GC, NGL = NCH_L / GC, NGRP = NGC + NGL;
static_assert(NCH_C % GC == 0 && NCH_L % GC == 0, "groups");
constexpr size_t PA0_QD = A0;
constexpr size_t PA0_KE = PA0_QD + AL((size_t)2 * T * 512 * 2);
constexpr size_t PA0_ATT = PA0_KE + AL((size_t)NU_GLA * 2 * 128 * 64 * 2);
constexpr size_t PA0_VT = PA0_ATT + AL((size_t)NU_GLA * 2 * 64 * 64 * 2);
constexpr size_t PA0_DEC = PA0_VT + AL((size_t)NU_GLA * 256 * 64 * 2);
constexpr size_t PA0_KVG = PA0_DEC + AL((size_t)NU_GLA * 2 * 128 * 4);
constexpr size_t PA0_DECG = PA0_KVG + AL((size_t)16 * NGRP * 32768 * 2);
constexpr size_t PA0_AT = PA0_DECG + AL((size_t)16 * NGRP * 128 * 4);
constexpr size_t PA0_HT = PA0_AT + AL((size_t)2 * BATCH * NCH * 1024 * 4);
constexpr size_t PA0_HIN = PA0_HT + AL((size_t)2 * BATCH * NCH * 1024 * 4);
constexpr size_t PA0_HL = PA0_HIN + AL((size_t)2 * BATCH * NCH * 1024 * 4);
constexpr size_t PA0_ACF = PA0_HL + AL((size_t)T * 1024 * 2);
constexpr size_t PA0_ACB = PA0_ACF + AL((size_t)T * 1024 * 2);
constexpr size_t PA0_END = PA0_ACB + AL((size_t)T * 1024 * 2);
constexpr size_t A1 = AL((size_t)T * NP1 * 2);
constexpr int MLV = 272;
constexpr size_t PA1_SM = A1;
constexpr size_t PA1_KEW = PA1_SM + AL((size_t)NU_ML * 2 * 64 * 64 * 2);
constexpr size_t PA1_VT = PA1_KEW + AL((size_t)NU_ML * 2 * 128 * 64 * 2);
constexpr size_t PA1_WF = PA1_VT + AL((size_t)NU_ML * MLV * 64 * 2);
constexpr size_t PA1_DEC = PA1_WF + AL((size_t)NU_ML * 4 * 64 * 4);
constexpr size_t PA1_KVG = PA1_DEC + AL((size_t)NU_ML * 2 * 4);
constexpr size_t PA1_DG = PA1_KVG + AL((size_t)32 * NGRP * MLV * 128 * 2);
constexpr size_t PA1_END = PA1_DG + AL((size_t)32 * NGRP * 4);
constexpr size_t PA_YMIX = 0;
constexpr size_t PA_H = PA_YMIX + AL((size_t)T * D * 2);
constexpr size_t PA_Y = PA_H + AL((size_t)NSLOT_MAX * DEXP * 2);
constexpr size_t PA_XB = PA_Y + AL((size_t)NSLOT_MAX * D * 2);
constexpr size_t PA_MOE_END = PA_XB + AL((size_t)T * D * 2);
constexpr size_t PA_BYTES = PA0_END > PA1_END ? (PA0_END > PA_MOE_END ? PA0_END : PA_MOE_END) : (PA1_END > PA_MOE_END ? PA1_END : PA_MOE_END);
constexpr size_t WS_END = WS_PA + PA_BYTES;
#ifndef CPU_EMU_SMALL
static_assert(WS_END <= (size_t)1408000000, "workspace map exceeds the guaranteed d_ws size");
#endif

#ifdef CPU_EMU
#define LAS
#define MFMA16(a, b, c) emu_mfma16(a, b, c)
#define RFL(x) (x)
static inline float fexp(float x) { return expf(x); }
#else
#define LAS __attribute__((address_space(3)))
#define MFMA16(a, b, c) __builtin_amdgcn_mfma_f32_16x16x32_bf16(a, b, c, 0, 0, 0)
#define RFL(x) __builtin_amdgcn_readfirstlane(x)
__device__ __forceinline__ float fexp(float x) { return __expf(x); }
#endif

__device__ __forceinline__ float bf2f(bf16_t h) { union { unsigned u; float f; } c; c.u = ((unsigned)h) << 16; return c.f; }
__device__ __forceinline__ bf16_t f2bf(float f) { union { float f; unsigned u; } c; c.f = f; unsigned u = c.u; u += 0x7FFFu + ((u >> 16) & 1u); return (bf16_t)(u >> 16); }
#ifdef CPU_EMU
__device__ __forceinline__ unsigned pk2(float lo, float hi) { return (unsigned)f2bf(lo) | ((unsigned)f2bf(hi) << 16); }
#else
__device__ __forceinline__ unsigned pk2(float lo, float hi) { unsigned r; asm("v_cvt_pk_bf16_f32 %0, %1, %2" : "=v"(r) : "v"(lo), "v"(hi)); return r; }
#endif
__device__ __forceinline__ bf16_t f2bf1(float f) { return (bf16_t)pk2(f, f); }
#ifdef CPU_EMU
__device__ __forceinline__ float frcp(float x) { return 1.f / x; }
__device__ __forceinline__ float fsqrt(float x) { return sqrtf(x); }
__device__ __forceinline__ float frsq(float x) { return 1.f / sqrtf(x); }
#else
__device__ __forceinline__ float frcp(float x) { return __builtin_amdgcn_rcpf(x); }
__device__ __forceinline__ float fsqrt(float x) { return __builtin_amdgcn_sqrtf(x); }
__device__ __forceinline__ float frsq(float x) { return __builtin_amdgcn_rsqf(x); }
#endif
__device__ __forceinline__ float sigmoidf_(float x) { return frcp(1.f + fexp(-x)); }
__device__ __forceinline__ float siluf_(float x) { return x * frcp(1.f + fexp(-x)); }
__device__ __forceinline__ float log_sigmoidf_(float x) { return fminf(x, 0.f) - log1pf(fexp(-fabsf(x))); }
__device__ __forceinline__ float gelu_tanhf_(float x) { const float u = 0.7978845608f * (x + 0.044715f * x * x * x); return x * frcp(1.f + fexp(-2.f * u)); }
__device__ __forceinline__ float wave_sum(float v) { v += __shfl_xor(v, 32); v += __shfl_xor(v, 16); v += __shfl_xor(v, 8); v += __shfl_xor(v, 4); v += __shfl_xor(v, 2); v += __shfl_xor(v, 1); return v; }
__device__ __forceinline__ bf16x8 frag(const bf16_t* base, int ld, int row0, int k0, int lane) { return *(const bf16x8*)(base + (size_t)(row0 + (lane & 15)) * ld + k0 + ((lane >> 4) << 3)); }
__device__ __forceinline__ bf16x8 frag_l(const bf16_t* base, int ld, int row0, int k0, int lane) { return *(const LAS bf16x8*)((const LAS bf16_t*)base + (row0 + (lane & 15)) * ld + k0 + ((lane >> 4) << 3)); }
#ifdef CPU_EMU
#define SCHED_BAR() do { } while (0)
#define OPAQUE(x) do { } while (0)
#else
#define SCHED_BAR() __builtin_amdgcn_sched_barrier(0)
#define OPAQUE(x) asm volatile("" : "+v"(x))
#endif
#ifdef CPU_EMU
#define MFMA_DRAIN() do { } while (0)
#else
#define MFMA_DRAIN() do { __builtin_amdgcn_sched_barrier(0); asm volatile("s_nop 15\n\ts_nop 15" ::: "memory"); __builtin_amdgcn_sched_barrier(0); } while (0)
#endif
__device__ __forceinline__ f32x4 fzero4() { f32x4 z = {0.f, 0.f, 0.f, 0.f}; return z; }

__device__ __forceinline__ int chunk_row0(int b, int c) { return c < NCH_C ? TL + b * CTX + 64 * c : b * SEQ + 64 * (c - NCH_C); }
__device__ __forceinline__ int scan_chunk(int dir, int i) { return dir == 0 ? i : (i < NCH_C ? NCH_C - 1 - i : NCH_C + (NCH_L - 1 - (i - NCH_C))); }
__device__ __forceinline__ int scan_group(int dir, int i) { return dir == 0 ? i : (i < NGC ? NGC - 1 - i : NGC + (NGL - 1 - (i - NGC))); }
__device__ __forceinline__ int group_chunk(int g, int dir, int j) { return g * GC + (dir ? GC - 1 - j : j); }
__device__ __forceinline__ int raster_of_p(int p) { const int b = p / SEQ, q = p % SEQ, w = q / GROWS, r = q % GROWS; return b * SEQ + r * GRIDW + w; }

struct Args {
    const float* in[31];
    float* out;
    unsigned char* ws;
    int ph_lo, ph_hi;
};

#ifndef CPU_EMU
#define XB_TMO      128
#define XB_XCNT(j)  (256  + 64 * (j))
#define XB_XSUB(j)  (1280 + 64 * (j))
#define XB_XGEN(j)  (2304 + 64 * (j))
#define XB_TOP      3328
#define XB_TOPGEN   3392
#define XCD_BAR_WORDS 3456
#define XB_SPIN_CAP (1u << 22)
__device__ __forceinline__ unsigned xb_ld(unsigned* p)              { return __hip_atomic_load(p, __ATOMIC_RELAXED, __HIP_MEMORY_SCOPE_AGENT); }
__device__ __forceinline__ unsigned xb_add(unsigned* p, unsigned v) { return __hip_atomic_fetch_add(p, v, __ATOMIC_RELAXED, __HIP_MEMORY_SCOPE_AGENT); }
__device__ __forceinline__ unsigned xb_xcc_id() { return (unsigned)__builtin_amdgcn_s_getreg((3 << 11) | 20) & 0xFu; }
#define XB_SPIN(cond, bar) do { unsigned _sp = 0; while (cond) { __builtin_amdgcn_s_sleep(1); \
    if ((++_sp & 255u) == 0u) { if (xb_ld(&(bar)[XB_TMO])) break; if (_sp > XB_SPIN_CAP) { atomicAdd(&(bar)[XB_TMO], 1u); break; } } } } while (0)
struct XcdBarrier { unsigned* bar; unsigned x; volatile LAS unsigned* st; };
__device__ __forceinline__ XcdBarrier xcd_barrier_post(unsigned* bar, volatile LAS unsigned* st) {
    XcdBarrier b; b.bar = bar; b.x = xb_xcc_id(); b.st = st;
    if (threadIdx.x == 0) (void)xb_add(&bar[XB_XCNT(b.x)], 1u);
    return b;
}
__device__ __forceinline__ void xcd_barrier_complete(unsigned* bar, unsigned x, unsigned& nloc, unsigned& nx) {
    const unsigned G = gridDim.x * gridDim.y * gridDim.z;
    unsigned sum, cnt, mine, sp = 0u;
    for (;;) {
        sum = 0u; cnt = 0u; mine = 0u;
#pragma unroll
        for (unsigned j = 0; j < 16; ++j) { const unsigned c = xb_ld(&bar[XB_XCNT(j)]); sum += c; cnt += (c > 0u) ? 1u : 0u; mine = (j == x) ? c : mine; }
        if (sum == G) break;
        __builtin_amdgcn_s_sleep(1);
        if ((++sp & 255u) == 0u) { if (xb_ld(&bar[XB_TMO])) break; if (sp > XB_SPIN_CAP) { atomicAdd(&bar[XB_TMO], 1u); break; } }
    }
    nloc = mine > 0u ? mine : 1u; nx = cnt > 0u ? cnt : 1u;
}
__device__ __forceinline__ void xcd_barrier(const XcdBarrier& b) {
    asm volatile("s_waitcnt vmcnt(0)" ::: "memory");
    __syncthreads();
    if (threadIdx.x == 0) {
        unsigned* bar = b.bar;
        __builtin_amdgcn_s_waitcnt(0);
        unsigned nloc = b.st[0], nx = b.st[1];
        if (nloc == 0u) { xcd_barrier_complete(bar, b.x, nloc, nx); b.st[0] = nloc; b.st[1] = nx; }
        const unsigned old = xb_add(&bar[XB_XSUB(b.x)], 1u);
        const unsigned gen = old / nloc;
        if (old + 1u == (gen + 1u) * nloc) {
            __builtin_amdgcn_fence(__ATOMIC_RELEASE, "agent");
            asm volatile("s_waitcnt vmcnt(0)" ::: "memory");
            const unsigned og = xb_add(&bar[XB_TOP], 1u);
            const unsigned tg = og / nx;
            if (og + 1u == (tg + 1u) * nx) xb_add(&bar[XB_TOPGEN], 1u);
            else XB_SPIN(xb_ld(&bar[XB_TOPGEN]) == tg, bar);
            __builtin_amdgcn_fence(__ATOMIC_ACQUIRE, "agent");
            xb_add(&bar[XB_XGEN(b.x)], 1u);
            asm volatile("s_waitcnt vmcnt(0)" ::: "memory");
        } else {
            XB_SPIN(xb_ld(&bar[XB_XGEN(b.x)]) == gen, bar);
            __builtin_amdgcn_fence(__ATOMIC_ACQUIRE, "agent");
            asm volatile("s_waitcnt vmcnt(0)" ::: "memory");
        }
    }
    __syncthreads();
}
#endif

constexpr int BM = 256, BK = 64, HALF = 128, HTB = HALF * BK * 2, STAGE_BYTES = 8 * HTB;
struct Unit { int pm, pn; };
struct Gemm { const bf16_t* A; const bf16_t* Bt; int K; const int* rowidx; };
__host__ __device__ __forceinline__ int lds_byte(int r, int c) { const int st = (r >> 4) * 2 + (c >> 5), rr = r & 15, cc = c & 31, ob = rr * 64 + cc * 2; return st * 1024 + (ob ^ (((ob >> 9) & 1) << 5)); }
__host__ __device__ __forceinline__ void stage_rc(int b, int& R, int& C) { const int st = b / 1024, sb = b % 1024, swz = sb ^ (((sb >> 9) & 1) << 5); R = (st >> 1) * 16 + swz / 64; C = (st & 1) * 32 + (swz % 64) / 2; }
__host__ __device__ __forceinline__ int perm32(int rho) { const int n = rho >> 4, i = rho & 15; return 8 * (i >> 2) + 4 * n + (i & 3); }

struct StaticOrder {
    int nM, nN, G, c;
    __device__ __forceinline__ bool next(int i, Unit& u) const {
        const int nU = nM * nN; long Q;
        if ((G & 7) == 0) { const int x = c & 7, l = c >> 3, W = G >> 3; const long s0 = (long)nU * x / 8, s1 = (long)nU * (x + 1) / 8; Q = s0 + (long)i * W + l; if (Q >= s1) return false; }
        else { Q = (long)i * G + c; if (Q >= nU) return false; }
        const int per = 4 * nN, gi = (int)(Q / per), rem = (int)(Q % per), rows = (nM - 4 * gi) < 4 ? (nM - 4 * gi) : 4;
        u.pn = rem / rows; u.pm = 4 * gi + rem % rows; return true;
    }
};
struct MoeOrder {
    const int* tile_e; int NT, ncol, G, c;
    __device__ __forceinline__ bool next(int i, Unit& u) const {
        const int nU = NT * ncol; long Q;
        if ((G & 7) == 0) { const int x = c & 7, l = c >> 3, W = G >> 3; const long s0 = (long)nU * x / 8, s1 = (long)nU * (x + 1) / 8; Q = s0 + (long)i * W + l; if (Q >= s1) return false; }
        else { Q = (long)i * G + c; if (Q >= nU) return false; }
        const int t = (int)(Q / ncol), j = (int)(Q % ncol); u.pm = t; u.pn = tile_e[t] * ncol + j; return true;
    }
};

#ifdef CPU_EMU
template <class Epi, class Sched>
__device__ __forceinline__ void gemm_phase(unsigned char* lds, const Gemm g, const Sched& S, const Epi& E) {
    const int tid = threadIdx.x, wid = tid >> 6, lane = tid & 63, wr = wid >> 2, wc = wid & 3, fr = lane & 15, fq = lane >> 4;
    Unit u;
    for (int ui = 0; S.next(ui, u); ++ui) {
        f32x4 acc[2][2][4][2];
        for (int ai = 0; ai < 2; ++ai) for (int m = 0; m < 4; ++m) {
            const int rr = 128 * ai + 64 * wr + 16 * m + fr;
            const size_t arow = g.rowidx ? (size_t)g.rowidx[256 * u.pm + rr] : (size_t)256 * u.pm + rr;
            const bf16_t* ap = g.A + arow * g.K;
            for (int bj = 0; bj < 2; ++bj) for (int n = 0; n < 2; ++n) for (int e = 0; e < 4; ++e) {
                const int col = 256 * u.pn + 128 * bj + 32 * wc + 8 * fq + 4 * n + e;
                const bf16_t* bp = g.Bt + (size_t)col * g.K;
                float s = 0.f; for (int k = 0; k < g.K; ++k) s += bf2f(ap[k]) * bf2f(bp[k]);
                acc[ai][bj][m][n][e] = s;
            }
        }
        E(acc, u, wr, wc, fr, fq);
    }
    (void)lds;
}
#else
template <class Epi, class Sched>
__device__ __forceinline__ void gemm_phase(LAS unsigned char* lds, const Gemm g, const Sched& S, const Epi& E) {
    const int tid = threadIdx.x, wid = __builtin_amdgcn_readfirstlane(tid >> 6), lane = tid & 63, wr = wid >> 2, wc = wid & 3, fr = lane & 15, fq = lane >> 4;
    const int K = g.K, nt = K / BK;
    int Rr[2], Cc[2];
    unsigned voffB[2];
#pragma unroll
    for (int i = 0; i < 2; ++i) { stage_rc(tid * 16 + i * 8192, Rr[i], Cc[i]); const int Rb = (Rr[i] & ~31) + perm32(Rr[i] & 31); voffB[i] = (unsigned)(Rb * K + Cc[i]) * 2u; }
    const size_t kstep = (size_t)(BK * 2);
    const size_t hstep = (size_t)HALF * K * 2;
    const size_t tstep = 2 * hstep;
    const unsigned ldsw = (unsigned)wid * 1024u;
    const int aoff = lds_byte(wr * 64 + fr, fq * 8), boff = lds_byte(wc * 32 + fr, fq * 8);
#define PG8_SA(b, h) (((b) * 2 + (h)) * HTB)
#define PG8_SB(b, h) ((4 + (b) * 2 + (h)) * HTB)
#define PG8_STAGE(bufoff, gbase, voff) do { _Pragma("unroll") for (int _i = 0; _i < 2; ++_i) \
        __builtin_amdgcn_global_load_lds((const unsigned*)((const char*)(gbase) + (voff)[_i]), (LAS unsigned*)(lds + (bufoff) + ldsw + _i * 8192), 16, 0, 0); } while (0)
#define PG8_LDA(dst, b, h) do { _Pragma("unroll") for (int m = 0; m < 4; ++m) _Pragma("unroll") for (int k = 0; k < 2; ++k) dst[m][k] = *(const LAS bf16x8*)(lds + PG8_SA(b, h) + aoff + m * 2048 + k * 1024); } while (0)
#define PG8_LDB(dst, b, h) do { _Pragma("unroll") for (int n = 0; n < 2; ++n) _Pragma("unroll") for (int k = 0; k < 2; ++k) dst[n][k] = *(const LAS bf16x8*)(lds + PG8_SB(b, h) + boff + n * 2048 + k * 1024); } while (0)
#define PG8_MMA(ai, bj, At, Bt) do { __builtin_amdgcn_s_setprio(1); _Pragma("unroll") for (int m = 0; m < 4; ++m) _Pragma("unroll") for (int n = 0; n < 2; ++n) _Pragma("unroll") for (int k = 0; k < 2; ++k) \
        acc[ai][bj][m][n] = __builtin_amdgcn_mfma_f32_16x16x32_bf16(Bt[n][k], At[m][k], acc[ai][bj][m][n], 0, 0, 0); __builtin_amdgcn_s_setprio(0); } while (0)
#define PG8_WAIT_V(n) asm volatile("s_waitcnt vmcnt(" #n ")" ::: "memory")
#define PG8_WAIT_L(n) asm volatile("s_waitcnt lgkmcnt(" #n ")" ::: "memory")
#define PG8_BAR __builtin_amdgcn_s_barrier()
#define PG8_SCHED __builtin_amdgcn_sched_barrier(0)
#define PG8_AOFF(dst, unit) do { _Pragma("unroll") for (int _h = 0; _h < 2; ++_h) _Pragma("unroll") for (int _i = 0; _i < 2; ++_i) { \
        const int _rr = _h * HALF + Rr[_i]; const unsigned _row = g.rowidx ? (unsigned)g.rowidx[(unit).pm * BM + _rr] : (unsigned)((unit).pm * BM + _rr); \
        dst[_h][_i] = (_row * (unsigned)K + (unsigned)Cc[_i]) * 2u; } } while (0)
    Unit cur, nxt; int ui = 0;
    if (!S.next(0, cur)) return;
    f32x4 acc[2][2][4][2];
#pragma unroll
    for (int a = 0; a < 2; ++a)
#pragma unroll
        for (int b = 0; b < 2; ++b)
#pragma unroll
            for (int m = 0; m < 4; ++m)
#pragma unroll
                for (int n = 0; n < 2; ++n) acc[a][b][m][n] = (f32x4){0.f, 0.f, 0.f, 0.f};
    bf16x8 At[4][2], B0[2][2], B1[2][2];
    unsigned oC[2][2], oN[2][2];
    PG8_AOFF(oC, cur);
    const char* const gA = (const char*)g.A;
    const char* cB = (const char*)g.Bt + (size_t)cur.pn * tstep;
    PG8_STAGE(PG8_SB(0, 0), cB, voffB); PG8_STAGE(PG8_SA(0, 0), gA, oC[0]); PG8_STAGE(PG8_SB(0, 1), cB + hstep, voffB); PG8_STAGE(PG8_SA(0, 1), gA, oC[1]);
    if (wr == 1) PG8_BAR;
    PG8_WAIT_V(4); PG8_BAR;
    PG8_STAGE(PG8_SB(1, 0), cB + kstep, voffB); PG8_STAGE(PG8_SA(1, 0), gA + kstep, oC[0]); PG8_STAGE(PG8_SB(1, 1), cB + hstep + kstep, voffB);
    PG8_WAIT_V(6); PG8_BAR;
    for (;;) {
        const bool has_next = S.next(ui + 1, nxt);
        if (has_next) { PG8_AOFF(oN, nxt); } else {
#pragma unroll
            for (int _h = 0; _h < 2; ++_h)
#pragma unroll
                for (int _i = 0; _i < 2; ++_i) oN[_h][_i] = oC[_h][_i]; }
        const char* nB = has_next ? (const char*)g.Bt + (size_t)nxt.pn * tstep : cB;
        for (int t = 0; t < nt; t += 2) {
            const bool last = (t == nt - 2);
            const char* a1 = gA + (size_t)(t + 1) * kstep;
            const char* a2 = last ? gA : gA + (size_t)(t + 2) * kstep; const char* b2 = last ? nB : cB + (size_t)(t + 2) * kstep;
            const char* a3 = a2 + kstep; const char* b3 = b2 + kstep;
            unsigned o2[2][2];
#pragma unroll
            for (int _h = 0; _h < 2; ++_h)
#pragma unroll
                for (int _i = 0; _i < 2; ++_i) o2[_h][_i] = last ? oN[_h][_i] : oC[_h][_i];
            PG8_LDB(B0, 0, 0); PG8_SCHED; PG8_LDA(At, 0, 0); PG8_STAGE(PG8_SA(1, 1), a1, oC[1]);
            PG8_WAIT_L(8); PG8_BAR; PG8_WAIT_L(0); PG8_MMA(0, 0, At, B0); PG8_BAR; PG8_SCHED;
            PG8_LDB(B1, 0, 1); PG8_STAGE(PG8_SB(0, 0), b2, voffB);
            PG8_BAR; PG8_WAIT_L(0); PG8_MMA(0, 1, At, B1); PG8_BAR;
            PG8_LDA(At, 0, 1); PG8_STAGE(PG8_SA(0, 0), a2, o2[0]);
            PG8_BAR; PG8_WAIT_L(0); PG8_MMA(1, 0, At, B0); PG8_BAR; PG8_SCHED;
            PG8_STAGE(PG8_SB(0, 1), b2 + hstep, voffB);
            PG8_WAIT_V(6); PG8_BAR; PG8_MMA(1, 1, At, B1); PG8_BAR;
            PG8_LDB(B0, 1, 0); PG8_SCHED; PG8_LDA(At, 1, 0); PG8_STAGE(PG8_SA(0, 1), a2, o2[1]);
            PG8_WAIT_L(8); PG8_BAR; PG8_WAIT_L(0); PG8_MMA(0, 0, At, B0); PG8_BAR; PG8_SCHED;
            PG8_LDB(B1, 1, 1); PG8_STAGE(PG8_SB(1, 0), b3, voffB);
            PG8_BAR; PG8_WAIT_L(0); PG8_MMA(0, 1, At, B1); PG8_BAR;
            PG8_LDA(At, 1, 1); PG8_STAGE(PG8_SA(1, 0), a3, o2[0]);
            PG8_BAR; PG8_WAIT_L(0); PG8_MMA(1, 0, At, B0); PG8_BAR; PG8_SCHED;
            PG8_STAGE(PG8_SB(1, 1), b3 + hstep, voffB);
            PG8_WAIT_V(6); PG8_BAR; PG8_MMA(1, 1, At, B1); PG8_BAR;
        }
        E(acc, cur, wr, wc, fr, fq);
        if (!has_next) break;
#pragma unroll
        for (int a = 0; a < 2; ++a)
#pragma unroll
            for (int b = 0; b < 2; ++b)
#pragma unroll
                for (int m = 0; m < 4; ++m)
#pragma unroll
                    for (int n = 0; n < 2; ++n) acc[a][b][m][n] = (f32x4){0.f, 0.f, 0.f, 0.f};
        cur = nxt; cB = nB; ++ui;
#pragma unroll
        for (int _h = 0; _h < 2; ++_h)
#pragma unroll
            for (int _i = 0; _i < 2; ++_i) oC[_h][_i] = oN[_h][_i];
    }
    PG8_WAIT_V(0);
    if (wr == 0) PG8_BAR;
    PG8_BAR;
#undef PG8_SA
#undef PG8_SB
#undef PG8_STAGE
#undef PG8_LDA
#undef PG8_LDB
#undef PG8_MMA
#undef PG8_WAIT_V
#undef PG8_WAIT_L
#undef PG8_BAR
#undef PG8_SCHED
#undef PG8_AOFF
}
#endif

struct EpiIn {
    bf16_t* P; int ldp; float* G; int np;
    __device__ __forceinline__ void operator()(const f32x4 (&acc)[2][2][4][2], const Unit& u, int wr, int wc, int fr, int fq) const {
        const int row0 = u.pm * BM + wr * 64 + fr;
        if (u.pn < np) {
            const int col0 = u.pn * BM + wc * 32 + 8 * fq;
#pragma unroll
            for (int ai = 0; ai < 2; ++ai)
#pragma unroll
                for (int m = 0; m < 4; ++m) { bf16_t* rowp = P + (size_t)(row0 + ai * HALF + m * 16) * ldp + col0;
#pragma unroll
                    for (int bj = 0; bj < 2; ++bj) { const f32x4 v0 = acc[ai][bj][m][0], v1 = acc[ai][bj][m][1];
                        u32x4 o; o[0] = pk2(v0[0], v0[1]); o[1] = pk2(v0[2], v0[3]); o[2] = pk2(v1[0], v1[1]); o[3] = pk2(v1[2], v1[3]);
                        *(u32x4*)(rowp + bj * HALF) = o; } }
        } else if (wc == 0) {
#pragma unroll
            for (int ai = 0; ai < 2; ++ai)
#pragma unroll
                for (int m = 0; m < 4; ++m) { float* rowp = G + (size_t)(row0 + ai * HALF + m * 16) * 32 + 8 * fq;
                    *(f32x4*)(rowp) = acc[ai][0][m][0]; *(f32x4*)(rowp + 4) = acc[ai][0][m][1]; }
        }
    }
};
struct EpiBf {
    bf16_t* O; int ldc;
    __device__ __forceinline__ void operator()(const f32x4 (&acc)[2][2][4][2], const Unit& u, int wr, int wc, int fr, int fq) const {
        const int row0 = u.pm * BM + wr * 64 + fr, col0 = u.pn * BM + wc * 32 + 8 * fq;
#pragma unroll
        for (int ai = 0; ai < 2; ++ai)
#pragma unroll
            for (int m = 0; m < 4; ++m) { bf16_t* rowp = O + (size_t)(row0 + ai * HALF + m * 16) * ldc + col0;
#pragma unroll
                for (int bj = 0; bj < 2; ++bj) { const f32x4 v0 = acc[ai][bj][m][0], v1 = acc[ai][bj][m][1];
                    u32x4 o; o[0] = pk2(v0[0], v0[1]); o[1] = pk2(v0[2], v0[3]); o[2] = pk2(v1[0], v1[1]); o[3] = pk2(v1[2], v1[3]);
                    *(u32x4*)(rowp + bj * HALF) = o; } }
    }
};
struct EpiMoe1 {
    bf16_t* H;
    __device__ __forceinline__ void operator()(const f32x4 (&acc)[2][2][4][2], const Unit& u, int wr, int wc, int fr, int fq) const {
        const int row0 = u.pm * BM + wr * 64 + fr, col0 = (u.pn & 3) * 128 + wc * 32 + 8 * fq;
#pragma unroll
        for (int ai = 0; ai < 2; ++ai)
#pragma unroll
            for (int m = 0; m < 4; ++m) { bf16_t* rowp = H + (size_t)(row0 + ai * HALF + m * 16) * DEXP + col0;
                float h[8];
#pragma unroll
                for (int n = 0; n < 2; ++n)
#pragma unroll
                    for (int e = 0; e < 4; ++e) h[4 * n + e] = siluf_(acc[ai][0][m][n][e]) * acc[ai][1][m][n][e];
                u32x4 o; o[0] = pk2(h[0], h[1]); o[1] = pk2(h[2], h[3]); o[2] = pk2(h[4], h[5]); o[3] = pk2(h[6], h[7]);
                *(u32x4*)rowp = o; }
    }
};
struct EpiMoe2 {
    bf16_t* Y; const float* slot_gate; int ncol;
    __device__ __forceinline__ void operator()(const f32x4 (&acc)[2][2][4][2], const Unit& u, int wr, int wc, int fr, int fq) const {
        const int row0 = u.pm * BM + wr * 64 + fr, col0 = (u.pn % ncol) * BM + wc * 32 + 8 * fq;
#pragma unroll
        for (int ai = 0; ai < 2; ++ai)
#pragma unroll
            for (int m = 0; m < 4; ++m) { const int row = row0 + ai * HALF + m * 16; bf16_t* rowp = Y + (size_t)row * D + col0;
#pragma unroll
                for (int bj = 0; bj < 2; ++bj) { const f32x4 v0 = acc[ai][bj][m][0], v1 = acc[ai][bj][m][1];
                    u32x4 o; o[0] = pk2(v0[0], v0[1]); o[1] = pk2(v0[2], v0[3]); o[2] = pk2(v1[0], v1[1]); o[3] = pk2(v1[2], v1[3]);
                    *(u32x4*)(rowp + bj * HALF) = o; } }
    }
};

#if defined(DIAG_SUB) && !defined(CPU_EMU)
#define DSUB_DECL unsigned long long dsub_t0 = 0
#define DSUB_BEGIN(id) do { if ((id) == DIAG_SUB && threadIdx.x == 0) dsub_t0 = wall_clock64(); } while (0)
#define DSUB_END(id) do { if ((id) == DIAG_SUB && threadIdx.x == 0) { volatile LAS unsigned long long* a_ = (volatile LAS unsigned long long*)((LAS unsigned char*)F.lds + 147456 - 32); *a_ = *a_ + (wall_clock64() - dsub_t0); } } while (0)
#else
#define DSUB_DECL do { } while (0)
#define DSUB_BEGIN(id) do { } while (0)
#define DSUB_END(id) do { } while (0)
#endif
struct Frame {
    const float* const* in; float* out; unsigned char* ws; unsigned char* lds;
    int tid, lane, wave, G, bid;
};
#define WSP(type, off) ((type*)(F.ws + (off)))
#define PAP(type, off) ((type*)(F.ws + WS_PA + (off)))

__device__ __forceinline__ void ctx_outproj(const Frame& F, const bf16_t* A, const bf16_t* Wt, bf16_t* O) {
    int tz = threadIdx.x; OPAQUE(tz);
    const int tid = tz, lane = tz & 63, w = RFL(tz >> 6);
    constexpr int NTC = (TC / 64) * (D / 64), KW = DMIX / 8, PLD = 68;
    float* sP = (float*)F.lds;
#pragma unroll 1
    for (int t = F.bid; t < NTC; t += F.G) { const int rt = t / (D / 64), ct = t % (D / 64);
        const bf16_t* Ab = A + (size_t)(TL + 64 * rt) * DMIX + w * KW; const bf16_t* Bb = Wt + (size_t)(64 * ct) * DMIX + w * KW;
        f32x4 acc[4][4];
#pragma unroll
        for (int nj = 0; nj < 4; ++nj)
#pragma unroll
            for (int mi = 0; mi < 4; ++mi) acc[nj][mi] = fzero4();
#pragma unroll 4
        for (int k0 = 0; k0 < KW; k0 += 32) { bf16x8 a[4], b[4];
#pragma unroll
            for (int i = 0; i < 4; ++i) { a[i] = frag(Ab, DMIX, 16 * i, k0, lane); b[i] = frag(Bb, DMIX, 16 * i, k0, lane); }
#pragma unroll
            for (int nj = 0; nj < 4; ++nj)
#pragma unroll
                for (int mi = 0; mi < 4; ++mi) acc[nj][mi] = MFMA16(b[nj], a[mi], acc[nj][mi]); }
        __syncthreads();
#pragma unroll
        for (int nj = 0; nj < 4; ++nj)
#pragma unroll
            for (int mi = 0; mi < 4; ++mi) *(f32x4*)(sP + ((size_t)w * 64 + 16 * mi + (lane & 15)) * PLD + 16 * nj + 4 * (lane >> 4)) = acc[nj][mi];
        __syncthreads();
        { const int m = tid >> 3, n0 = (tid & 7) * 8; f32x4 s0 = fzero4(), s1 = fzero4();
#pragma unroll
          for (int q = 0; q < 8; ++q) { s0 += *(const f32x4*)(sP + ((size_t)q * 64 + m) * PLD + n0); s1 += *(const f32x4*)(sP + ((size_t)q * 64 + m) * PLD + n0 + 4); }
          u32x4 pk; pk[0] = pk2(s0[0], s0[1]); pk[1] = pk2(s0[2], s0[3]); pk[2] = pk2(s1[0], s1[1]); pk[3] = pk2(s1[2], s1[3]);
          *(u32x4*)(O + (size_t)(TL + 64 * rt + m) * D + 64 * ct + n0) = pk; }
    }
    __syncthreads();
}

struct CvtD { const float* p; unsigned ld; float scale; int valid; bf16_t* dst; int dst_ld, n0, k0, nvalid; };
__device__ __forceinline__ f32x4 ld4(const float* p) { return *(const f32x4*)p; }
__device__ __forceinline__ void cvt_issue(const CvtD& d, f32x4 (&v)[8]) {
#pragma unroll
    for (int i = 0; i < 8; ++i) { f32x4 x = {0.f, 0.f, 0.f, 0.f}; if (d.valid) x = ld4(d.p + (size_t)(8 * i) * d.ld); v[i] = x; }
}
template <class Next>
__device__ __forceinline__ void cvt_finish(const Frame& F, f32x4 (&v)[8], const CvtD& d, Next issue_next) {
    float* tile = (float*)F.lds;
    { const int n4 = (F.tid & 63) * 4, kk0 = F.tid >> 6;
#pragma unroll
      for (int i = 0; i < 8; ++i) { const int kk = kk0 + 8 * i; *(f32x4*)(tile + kk * 260 + (n4 ^ (4 * ((kk >> 3) & 7)))) = v[i] * d.scale; } }
    issue_next();
    __syncthreads();
#pragma unroll
    for (int i = 0; i < 4; ++i) { const int id = F.tid + NTHREADS * i, kc = id & 7, nn = id >> 3;
        if (nn < d.nvalid) { float x[8];
#pragma unroll
            for (int e = 0; e < 8; ++e) x[e] = tile[(kc * 8 + e) * 260 + (nn ^ (4 * kc))];
            u32x4 pk; pk[0] = pk2(x[0], x[1]); pk[1] = pk2(x[2], x[3]); pk[2] = pk2(x[4], x[5]); pk[3] = pk2(x[6], x[7]);
            *(u32x4*)(d.dst + (size_t)(d.n0 + nn) * d.dst_ld + d.k0 + kc * 8) = pk; } }
    __syncthreads();
}

__device__ __forceinline__ CvtD moe_cvt_desc(const Frame& F, int l, int t) {
    const float* wg = F.in[28] + (size_t)l * NEXP * D * DEXP; const float* wu = F.in[29] + (size_t)l * NEXP * D * DEXP; const float* wd = F.in[30] + (size_t)l * NEXP * DEXP * D;
    constexpr int T1 = (1024 / 256) * (D / 64), T2 = (D / 256) * (DEXP / 64);
    const int n4 = (F.tid & 63) * 4, kk0 = F.tid >> 6;
    const int e = t / (T1 + T2), r = t % (T1 + T2);
    CvtD d; d.scale = 1.f; d.valid = 1; d.nvalid = 256;
    if (r < T1) { const int nt_ = r / (D / 64), kt = r % (D / 64); d.n0 = nt_ * 256; d.k0 = kt * 64;
        const float* base = (n4 < 128) ? wg + (size_t)e * D * DEXP + 128 * nt_ + n4 : wu + (size_t)e * D * DEXP + 128 * nt_ + n4 - 128;
        d.p = base + (size_t)(d.k0 + kk0) * DEXP; d.ld = DEXP; d.dst = WSP(bf16_t, WS_MOEW1) + (size_t)e * 1024 * D; d.dst_ld = D; }
    else { const int r2 = r - T1, nt_ = r2 / (DEXP / 64), kt = r2 % (DEXP / 64); d.n0 = nt_ * 256; d.k0 = kt * 64;
        d.p = wd + (size_t)e * DEXP * D + (size_t)(d.k0 + kk0) * D + d.n0 + n4; d.ld = D; d.dst = WSP(bf16_t, WS_MOEW2) + (size_t)e * D * DEXP; d.dst_ld = DEXP; }
    return d;
}
__device__ __forceinline__ void moe_weight_cvt(const Frame& F, int l, unsigned* queue = nullptr) {
    constexpr int T1 = (1024 / 256) * (D / 64), T2 = (D / 256) * (DEXP / 64);
    const int ntile = NEXP * (T1 + T2);
    int* sNext = (int*)(F.lds + 66560 + 1024);
    CvtD dc, dn; f32x4 v[8];
    if (!queue) {
        int t = F.bid; if (t >= ntile) return;
        dc = moe_cvt_desc(F, l, t); cvt_issue(dc, v);
#pragma unroll 1
        while (t < ntile) { const int tn = t + F.G; const bool hn = tn < ntile;
            cvt_finish(F, v, dc, [&]() { if (hn) { dn = moe_cvt_desc(F, l, tn); cvt_issue(dn, v); } });
            dc = dn; t = tn; }
    } else {
#ifdef CPU_EMU
#define CVT_CLAIM() (int)atomicAdd(queue, 1u)
#else
#define CVT_CLAIM() (int)__hip_atomic_fetch_add(queue, 1u, __ATOMIC_RELAXED, __HIP_MEMORY_SCOPE_AGENT)
#endif
        __syncthreads(); if (F.tid == 0) { sNext[0] = CVT_CLAIM(); sNext[1] = CVT_CLAIM(); } __syncthreads();
        int t = sNext[0], tn = sNext[1];
        __syncthreads();
        if (t >= ntile) return;
        dc = moe_cvt_desc(F, l, t); cvt_issue(dc, v);
#pragma unroll 1
        while (t < ntile) { const bool hn = tn < ntile;
            cvt_finish(F, v, dc, [&]() { if (F.tid == 0) sNext[0] = CVT_CLAIM(); if (hn) { dn = moe_cvt_desc(F, l, tn); cvt_issue(dn, v); } });
            dc = dn; t = tn; tn = sNext[0]; __syncthreads(); }
#undef CVT_CLAIM
    }
}

__device__ __forceinline__ CvtD pro_cvt_desc(const Frame& F, int t) {
    constexpr int KT = D / 64;
    constexpr int J0 = (NW0 / 256) * KT, J1 = (NW1 / 256) * KT, J2 = (D / 256) * (DMIX / 64), J3 = J2, J4 = 32 * 2;
    const int n4 = (F.tid & 63) * 4, kk0 = F.tid >> 6;
    CvtD d; d.scale = 1.f; d.valid = 1; d.nvalid = 256; int r = t;
    if (r < J0) { const int nt_ = r / KT, kt = r % KT; const float* src = F.in[8]; d.n0 = nt_ * 256; d.k0 = kt * 64; const int n = d.n0 + n4; int cn = 0;
        if (n < 3072) cn = n; else if (n < 5120) cn = n + 32; else if (n < 5152) cn = n - 5120 + 3072; else d.valid = 0;
        d.p = src + (size_t)(d.k0 + kk0) * 5152 + cn; d.ld = 5152; if (n < 512) d.scale = 0.08838834764831845f; d.dst = WSP(bf16_t, WS_WIN0); d.dst_ld = D; return d; }
    r -= J0;
    if (r < J1) { const int nt_ = r / KT, kt = r % KT; const float* src = F.in[20]; d.n0 = nt_ * 256; d.k0 = kt * 64; const int n = d.n0 + n4;
        if (n >= 6176) d.valid = 0;
        d.p = src + (size_t)(d.k0 + kk0) * 6176 + (n < 6176 ? n : 0); d.ld = 6176; if (n >= 1024 && n < 2048) d.scale = 0.08838834764831845f; d.dst = WSP(bf16_t, WS_WIN1); d.dst_ld = D; return d; }
    r -= J1;
    if (r < J2 + J3) { const int which = r / J2; r %= J2; const int nt_ = r / (DMIX / 64), kt = r % (DMIX / 64); const float* src = F.in[which ? 23 : 19]; d.n0 = nt_ * 256; d.k0 = kt * 64;
        d.p = src + (size_t)(d.k0 + kk0) * D + d.n0 + n4; d.ld = D; d.dst = WSP(bf16_t, which ? WS_WOUT1 : WS_WOUT0); d.dst_ld = DMIX; return d; }
    r -= J2 + J3;
    if (r < J4) { const int mat = r / 2, kt = r % 2; const int dir = mat >> 4, gate = (mat >> 3) & 1, nb = mat & 7;
        const float* src = F.in[gate ? 16 : 14] + ((size_t)dir * 8 + nb) * 128 * 128;
        d.n0 = 0; d.k0 = kt * 64; if (n4 >= 128) d.valid = 0;
        d.p = src + (size_t)(d.k0 + kk0) * 128 + (n4 < 128 ? n4 : 0); d.ld = 128; d.dst = WSP(bf16_t, WS_WLRU) + (size_t)mat * 128 * 128; d.dst_ld = 128; d.nvalid = 128; return d; }
    r -= J4;
    { const int l = r / KT, kt = r % KT; const float* wgp = F.in[24] + (size_t)l * D * 4; const float* wep = F.in[26] + (size_t)l * D * 32;
      d.n0 = 0; d.k0 = kt * 64; d.nvalid = 48;
      if (n4 < 4) { d.p = wgp + (size_t)(d.k0 + kk0) * 4; d.ld = 4; } else if (n4 < 36) { d.p = wep + (size_t)(d.k0 + kk0) * 32 + n4 - 4; d.ld = 32; } else { d.p = wgp; d.ld = 0; d.valid = 0; }
      d.dst = WSP(bf16_t, WS_WR) + (size_t)l * 48 * D; d.dst_ld = D; return d; }
}

__device__ __forceinline__ void phase_prologue(const Frame& F) {
    {
        float* sS = (float*)F.lds;
        float* sRed = sS + 3 * D;
        float* MODS = WSP(float, WS_MODS);
        constexpr int NJB = 6 * D / 128;
        bool have = false;
        for (int u = F.bid; u < 2 * NJB; u += F.G) {
            if (!have) { for (int i = F.tid; i < 3 * D; i += NTHREADS) { const int r = i / D, k = i % D; const float c = r < 2 ? F.in[1][r * D + k] : F.in[3][k]; sS[i] = siluf_(c); } __syncthreads(); have = true; }
            const int l = u / NJB, jb = u % NJB;
            const int cg = F.tid & 31, kg = F.tid >> 5;
            const float* W = F.in[4] + (size_t)l * D * 6 * D + jb * 128 + cg * 4;
            float a[3][4];
#pragma unroll
            for (int r = 0; r < 3; ++r)
#pragma unroll
                for (int e = 0; e < 4; ++e) a[r][e] = 0.f;
#pragma unroll 16
            for (int k = kg; k < D; k += 16) { const f32x4 w = *(const f32x4*)(W + (size_t)k * 6 * D);
#pragma unroll
                for (int r = 0; r < 3; ++r) { const float s = sS[r * D + k];
#pragma unroll
                    for (int e = 0; e < 4; ++e) a[r][e] += s * w[e]; } }
#pragma unroll
            for (int r = 0; r < 3; ++r)
#pragma unroll
                for (int e = 0; e < 4; ++e) sRed[(kg * 3 + r) * 128 + cg * 4 + e] = a[r][e];
            __syncthreads();
            if (F.tid < 384) { const int r = F.tid >> 7, j = F.tid & 127; float s = 0.f;
#pragma unroll
                for (int q = 0; q < 16; ++q) s += sRed[(q * 3 + r) * 128 + j];
                MODS[((size_t)l * 3 + r) * 6 * D + jb * 128 + j] = s + F.in[5][(size_t)l * 6 * D + jb * 128 + j]; }
            __syncthreads();
        }
        __syncthreads();
    }
    {
        constexpr int KT = D / 64;
        constexpr int JT = (NW0 / 256) * KT + (NW1 / 256) * KT + 2 * (D / 256) * (DMIX / 64) + 32 * 2 + 2 * KT;
        CvtD dc, dn; f32x4 v[8];
        int t = F.bid;
        if (t < JT) { dc = pro_cvt_desc(F, t); cvt_issue(dc, v); }
#pragma unroll 1
        while (t < JT) { const int tn = t + F.G; const bool hn = tn < JT;
            cvt_finish(F, v, dc, [&]() { if (hn) { dn = pro_cvt_desc(F, tn); cvt_issue(dn, v); } });
            dc = dn; t = tn; }
    }
}

__device__ __forceinline__ void phase_modulate0(const Frame& F) {
    const float* MODS = WSP(float, WS_MODS);
    bf16_t* U = WSP(bf16_t, WS_ACT);
    constexpr size_t n4 = (size_t)T * D / 4;
    for (size_t i0 = (size_t)F.bid * NTHREADS * 4 + F.tid; i0 < n4; i0 += (size_t)F.G * NTHREADS * 4) {
        f32x4 x[4], sh[4], sc[4]; int row[4], col[4];
#pragma unroll
        for (int k = 0; k < 4; ++k) { const size_t i = i0 + (size_t)k * NTHREADS; if (i < n4) { row[k] = (int)(i / (D / 4)); col[k] = (int)(i % (D / 4)) * 4;
            const int r = row[k] < TL ? row[k] / SEQ : 2;
            const float* xr = row[k] < TL ? F.in[0] + (size_t)row[k] * D : F.in[2] + (size_t)(row[k] - TL) * D;
            x[k] = *(const f32x4*)(xr + col[k]); sh[k] = *(const f32x4*)(MODS + (size_t)r * 6 * D + col[k]); sc[k] = *(const f32x4*)(MODS + (size_t)r * 6 * D + D + col[k]); } }
#pragma unroll
        for (int k = 0; k < 4; ++k) { const size_t i = i0 + (size_t)k * NTHREADS; if (i < n4) {
            u32x2 o; o[0] = pk2(x[k][0] * (1.f + sc[k][0]) + sh[k][0], x[k][1] * (1.f + sc[k][1]) + sh[k][1]); o[1] = pk2(x[k][2] * (1.f + sc[k][2]) + sh[k][2], x[k][3] * (1.f + sc[k][3]) + sh[k][3]);
            *(u32x2*)(U + (size_t)row[k] * D + col[k]) = o; } }
    }
}

__device__ __forceinline__ float fast_log_sigmoid(float z) {
#ifdef CPU_EMU
    return log_sigmoidf_(z);
#else
    return fminf(z, 0.f) - __logf(1.f + __expf(-fabsf(z)));
#endif
}
__device__ __forceinline__ void gla_vg_load(const Frame& F, int ug, u32x4 (&pv)[4], float (&pg)[4]) {
    const int h = ug & 3, bc = ug >> 2, b = bc / NCH, c = bc % NCH, row0 = chunk_row0(b, c);
    const bf16_t* P = PAP(bf16_t, PA_P); const float* Gt = WSP(float, WS_G); const int tid = threadIdx.x;
#pragma unroll
    for (int i = 0; i < 4; ++i) { const int idx = tid + NTHREADS * i, s_ = idx >> 5, vc = idx & 31; pv[i] = *(const u32x4*)(P + (size_t)(row0 + s_) * NP0 + 1024 + h * 256 + vc * 8); }
#pragma unroll
    for (int i = 0; i < 4; ++i) { const int idx = tid + NTHREADS * i; pg[i] = Gt[(size_t)(row0 + (idx >> 5)) * 32 + (idx & 31)]; }
}
struct GlaPar { float wa[2][16]; float bias[2]; };
__device__ __forceinline__ void gla_par_load(const Frame& F, int h, GlaPar& gp) {
    const int d = threadIdx.x & 127;
#pragma unroll
    for (int dir = 0; dir < 2; ++dir) { gp.bias[dir] = F.in[10][dir * 512 + h * 128 + d];
#pragma unroll
        for (int r = 0; r < 16; ++r) gp.wa[dir][r] = F.in[9][((size_t)16 * dir + r) * 512 + h * 128 + d]; }
}
__device__ __forceinline__ void gla_prep_unit(const Frame& F, int ug, int ug_next, u32x4 (&pv)[4], float (&pg)[4], const GlaPar& gp) {
    const int h = ug & 3, bc = ug >> 2, b = bc / NCH, c = bc % NCH, row0 = chunk_row0(b, c);
    const bf16_t* P = PAP(bf16_t, PA_P);
    float* sG = (float*)(F.lds + 0);
    float* sLa = (float*)(F.lds + 24576);
    bf16_t* sV = (bf16_t*)(F.lds + 24576);
    bf16_t* sQ = (bf16_t*)(F.lds + 58368);
    bf16_t* sKi = (bf16_t*)(F.lds + 75776);
    bf16_t* sKeT = (bf16_t*)(F.lds + 93184);
    float* sBl = (float*)(F.lds + 111616);
    float* sSeg = (float*)(F.lds + 112128);
    int tz = threadIdx.x; OPAQUE(tz);
    const int tid = tz, lane = tz & 63, w = RFL(tz >> 6);
    bf16x8 qr[2], kr[2];
#pragma unroll
    for (int i = 0; i < 4; ++i) { const int idx = tid + NTHREADS * i, s_ = idx >> 5, vc = idx & 31; *(u32x4*)(sV + s_ * 264 + ((vc ^ ((s_ >> 3) & 7)) * 8)) = pv[i]; }
#pragma unroll
    for (int i = 0; i < 2; ++i) { const int idx = tid + NTHREADS * i, t = idx >> 4, d0 = (idx & 15) * 8;
        qr[i] = *(const bf16x8*)(P + (size_t)(row0 + t) * NP0 + h * 128 + d0); kr[i] = *(const bf16x8*)(P + (size_t)(row0 + t) * NP0 + 512 + h * 128 + d0); }
#pragma unroll
    for (int i = 0; i < 4; ++i) sG[tid + NTHREADS * i] = pg[i];
    if (ug_next >= 0) gla_vg_load(F, ug_next, pv, pg);
    __syncthreads();
    { bf16_t* VT = PAP(bf16_t, PA0_VT) + (size_t)ug * 256 * 64;
#pragma unroll
      for (int i = 0; i < 4; ++i) { const int idx = tid + NTHREADS * i, v = idx >> 3, sc = idx & 7; bf16x8 o;
#pragma unroll
          for (int e = 0; e < 8; ++e) o[e] = (short)sV[(sc * 8 + e) * 264 + ((((v >> 3) ^ sc) << 3) | (v & 7))];
          *(bf16x8*)(VT + v * 64 + sc * 8) = o; } }
    __syncthreads();
#pragma unroll 1
    for (int dir = 0; dir < 2; ++dir) {
        { const int d = tid & 127, tq = tid >> 7; const float bias = dir ? gp.bias[1] : gp.bias[0];
#pragma unroll 4
          for (int i = 0; i < 16; ++i) { const int t = tq * 16 + i; f32x2 z2 = {bias, 0.f};
#pragma unroll
              for (int r = 0; r < 16; r += 2) { const f32x2 g2 = *(const f32x2*)(sG + t * 32 + dir * 16 + r); const f32x2 w2 = {dir ? gp.wa[1][r] : gp.wa[0][r], dir ? gp.wa[1][r + 1] : gp.wa[0][r + 1]}; z2 += g2 * w2; }
              sLa[t * 128 + d] = fast_log_sigmoid(z2[0] + z2[1]) * (1.f / 16.f); } }
        __syncthreads();
        { const int d = tid & 127, sg = tid >> 7; float v[16]; float run = 0.f;
#pragma unroll
          for (int i = 0; i < 16; ++i) { const int p = 16 * sg + i, t = dir ? 63 - p : p; run += sLa[t * 128 + d]; v[i] = run; }
          sSeg[sg * 128 + d] = run;
          __syncthreads();
          float off = 0.f;
          for (int s2 = 0; s2 < sg; ++s2) off += sSeg[s2 * 128 + d];
#pragma unroll
          for (int i = 0; i < 16; ++i) { const int p = 16 * sg + i, t = dir ? 63 - p : p; sLa[t * 128 + d] = v[i] + off; }
          if (sg == 3) { const float et = fexp(run + off); sBl[d] = et; PAP(float, PA0_DEC)[((size_t)ug * 2 + dir) * 128 + d] = et; } }
        __syncthreads();
        { bf16_t* QD = PAP(bf16_t, PA0_QD) + (size_t)dir * T * 512;
#pragma unroll
          for (int i = 0; i < 2; ++i) { const int idx = tid + NTHREADS * i, t = idx >> 4, d0 = (idx & 15) * 8;
              float qd[8], ki[8];
#pragma unroll
              for (int e = 0; e < 8; ++e) { const float e1 = fexp(sLa[t * 128 + d0 + e]), e2 = frcp(e1); const float kf = bf2f((bf16_t)kr[i][e]);
                  qd[e] = bf2f((bf16_t)qr[i][e]) * e1; ki[e] = kf * e2; sKeT[(d0 + e) * 66 + t] = f2bf1(ki[e] * sBl[d0 + e]); }
              u32x4 pq, pk; pq[0] = pk2(qd[0], qd[1]); pq[1] = pk2(qd[2], qd[3]); pq[2] = pk2(qd[4], qd[5]); pq[3] = pk2(qd[6], qd[7]);
              pk[0] = pk2(ki[0], ki[1]); pk[1] = pk2(ki[2], ki[3]); pk[2] = pk2(ki[4], ki[5]); pk[3] = pk2(ki[6], ki[7]);
              *(u32x4*)(sQ + t * 136 + d0) = pq; *(u32x4*)(sKi + t * 136 + d0) = pk;
              *(u32x4*)(QD + (size_t)(row0 + t) * 512 + h * 128 + d0) = pq; } }
        __syncthreads();
        { const int mt = w & 3, nt0 = (w >> 2) * 2; bf16_t* ATT = PAP(bf16_t, PA0_ATT) + ((size_t)ug * 2 + dir) * 64 * 64;
          const int t = 16 * mt + (lane & 15);
#pragma unroll
          for (int nn = 0; nn < 2; ++nn) { const int nt_ = nt0 + nn; f32x4 acc = fzero4();
#pragma unroll
              for (int ks = 0; ks < 4; ++ks) acc = MFMA16(frag_l(sKi, 136, 16 * nt_, 32 * ks, lane), frag_l(sQ, 136, 16 * mt, 32 * ks, lane), acc);
              const int s0 = 16 * nt_ + 4 * (lane >> 4); float m4[4];
#pragma unroll
              for (int j = 0; j < 4; ++j) { const int s_ = s0 + j; const bool keep = dir == 0 ? (s_ <= t) : (s_ >= t); m4[j] = keep ? acc[j] : 0.f; }
              u32x2 pk; pk[0] = pk2(m4[0], m4[1]); pk[1] = pk2(m4[2], m4[3]); *(u32x2*)(ATT + t * 64 + s0) = pk; }
          bf16_t* KE = PAP(bf16_t, PA0_KE) + ((size_t)ug * 2 + dir) * 128 * 64;
#pragma unroll
          for (int i = 0; i < 2; ++i) { const int idx = tid + NTHREADS * i, d = idx >> 3, sc = idx & 7; const unsigned* kp = (const unsigned*)(sKeT + d * 66 + sc * 8); u32x4 kv; kv[0] = kp[0]; kv[1] = kp[1]; kv[2] = kp[2]; kv[3] = kp[3]; *(u32x4*)(KE + d * 64 + sc * 8) = kv; } }
        __syncthreads();
    }
}

__device__ __forceinline__ void unpack8(const u32x4 x, float (&f)[8]);
__device__ __forceinline__ void lru_tile_load(const Frame& F, int ul, u32x4 (&tr)[3]) {
    const int nb = ul & 7, bc = ul >> 3, b = bc / NCH, c = bc % NCH;
    const int pos0 = c < NCH_C ? 64 * c : 64 * (c - NCH_C), seqlen = c < NCH_C ? CTX : SEQ, rbase = c < NCH_C ? TL + b * CTX : b * SEQ;
    const bf16_t* P = PAP(bf16_t, PA_P);
#pragma unroll
    for (int i = 0; i < 3; ++i) { const int idx = (int)threadIdx.x + NTHREADS * i, rr = idx >> 4, cc = idx & 15, pos = pos0 + rr - 2; u32x4 x = {0u, 0u, 0u, 0u};
        if (idx < 67 * 16 && pos >= 0 && pos < seqlen) x = *(const u32x4*)(P + (size_t)(rbase + pos) * NP0 + 3072 + nb * 128 + cc * 8);
        tr[i] = x; }
}
struct LruPar { float cb, cw[4]; float brb[2], bib[2], lsl8[2]; bf16x8 wr[2][4], wi[2][4]; };
__device__ __forceinline__ void lru_par_load(const Frame& F, int nb, LruPar& lp) {
    const int tid = threadIdx.x, ch = tid & 127, chm = nb * 128 + 16 * (tid >> 6) + (tid & 15);
    lp.cb = F.in[13][nb * 128 + ch];
#pragma unroll
    for (int j = 0; j < 4; ++j) lp.cw[j] = F.in[12][j * 1024 + nb * 128 + ch];
#pragma unroll
    for (int dir = 0; dir < 2; ++dir) { lp.brb[dir] = F.in[15][dir * 1024 + chm]; lp.bib[dir] = F.in[17][dir * 1024 + chm]; lp.lsl8[dir] = 8.f * fast_log_sigmoid(F.in[18][dir * 1024 + chm]); }
#pragma unroll
    for (int dir = 0; dir < 2; ++dir) { const bf16_t* Wr = WSP(bf16_t, WS_WLRU) + (size_t)((2 * dir) * 8 + nb) * 128 * 128; const bf16_t* Wi = WSP(bf16_t, WS_WLRU) + (size_t)((2 * dir + 1) * 8 + nb) * 128 * 128;
#pragma unroll
        for (int ks = 0; ks < 4; ++ks) { lp.wr[dir][ks] = frag(Wr, 128, 16 * (tid >> 6), 32 * ks, tid & 63); lp.wi[dir][ks] = frag(Wi, 128, 16 * (tid >> 6), 32 * ks, tid & 63); } }
}
__device__ __forceinline__ void lru_prep_unit(const Frame& F, int ul, int ul_next, u32x4 (&tr)[3], const LruPar& lp) {
    const int nb = ul & 7, bc = ul >> 3, b = bc / NCH, c = bc % NCH, row0 = chunk_row0(b, c);
    constexpr int LST = 132;
    float* sX = (float*)(F.lds + 0);
    float* sA = sX;
    bf16_t* sXcb = (bf16_t*)(F.lds + 34816);
    float* sU = (float*)(F.lds + 52224);
    float* sH = (float*)(F.lds + 86016);
    float* sSegA = (float*)(F.lds + 119808);
    float* sSegH = (float*)(F.lds + 121856);
    int tz = threadIdx.x; OPAQUE(tz);
    const int tid = tz, lane = tz & 63, w = RFL(tz >> 6);
#pragma unroll
    for (int i = 0; i < 3; ++i) { const int idx = tid + NTHREADS * i; if (idx < 67 * 16) { float x8[8]; unpack8(tr[i], x8); const int rr = idx >> 4, cc = idx & 15;
#pragma unroll
        for (int e = 0; e < 8; ++e) sX[rr * 128 + cc * 8 + e] = x8[e]; } }
    if (ul_next >= 0) lru_tile_load(F, ul_next, tr);
    __syncthreads();
    { const int ch = tid & 127, tq = tid >> 7;
#pragma unroll 4
      for (int i = 0; i < 16; ++i) { const int t = tq * 16 + i; float xc = lp.cb;
#pragma unroll
          for (int j = 0; j < 4; ++j) xc += sX[(t + j) * 128 + ch] * lp.cw[j];
          sXcb[t * 136 + ch] = f2bf1(xc); } }
    __syncthreads();
#pragma unroll 1
    for (int dir = 0; dir < 2; ++dir) {
        { f32x4 ar[4], ai_[4];
#pragma unroll
          for (int m = 0; m < 4; ++m) { ar[m] = fzero4(); ai_[m] = fzero4(); }
          const int d = 16 * w + (lane & 15);
          const float brb = dir ? lp.brb[1] : lp.brb[0], bib = dir ? lp.bib[1] : lp.bib[0], lsl8 = dir ? lp.lsl8[1] : lp.lsl8[0];
#pragma unroll
          for (int ks = 0; ks < 4; ++ks) { bf16x8 a4[4];
#pragma unroll
              for (int m = 0; m < 4; ++m) a4[m] = frag_l(sXcb, 136, 16 * m, 32 * ks, lane);
              const bf16x8 wrk = dir ? lp.wr[1][ks] : lp.wr[0][ks], wik = dir ? lp.wi[1][ks] : lp.wi[0][ks];
#pragma unroll
              for (int m = 0; m < 4; ++m) { ar[m] = MFMA16(a4[m], wrk, ar[m]); ai_[m] = MFMA16(a4[m], wik, ai_[m]); } }
#pragma unroll
          for (int m = 0; m < 4; ++m)
#pragma unroll
              for (int j = 0; j < 4; ++j) { const int t = 16 * m + 4 * (lane >> 4) + j;
                  const float r = frcp(1.f + fexp(-(ar[m][j] + brb))), ig = frcp(1.f + fexp(-(ai_[m][j] + bib))), a = fexp(r * lsl8);
                  const float u = fsqrt(fmaxf(1.f - a * a, 0.f)) * ig * bf2f(sXcb[t * 136 + d]);
                  sA[t * LST + d] = a; sU[t * LST + d] = u; } }
        __syncthreads();
        { const int ch = tid & 127, sg = tid >> 7; float hl[16], ac[16]; float hh = 0.f, A = 1.f;
#pragma unroll
          for (int i = 0; i < 16; ++i) { const int p = 16 * sg + i, t = dir ? 63 - p : p; const float a = sA[t * LST + ch]; hh = a * hh + sU[t * LST + ch]; A *= a; hl[i] = hh; ac[i] = A; }
          sSegA[sg * 128 + ch] = A; sSegH[sg * 128 + ch] = hh;
          __syncthreads();
          const size_t ix = (((size_t)dir * BATCH + b) * NCH + c) * 1024 + nb * 128 + ch;
          float st = 0.f, ap = 1.f;
          for (int s2 = 0; s2 < sg; ++s2) { st = sSegA[s2 * 128 + ch] * st + sSegH[s2 * 128 + ch]; ap *= sSegA[s2 * 128 + ch]; }
          if (sg == 3) { PAP(float, PA0_AT)[ix] = ap * A; PAP(float, PA0_HT)[ix] = A * st + hh; }
#pragma unroll
          for (int i = 0; i < 16; ++i) { const int p = 16 * sg + i, t = dir ? 63 - p : p; const float hv = hl[i] + ac[i] * st; sA[t * LST + ch] = ap * ac[i]; if (dir == 0) sH[t * LST + ch] = hv; else sH[t * LST + ch] += hv; } }
        __syncthreads();
        { bf16_t* AC = PAP(bf16_t, dir ? PA0_ACB : PA0_ACF); bf16_t* HL = PAP(bf16_t, PA0_HL);
#pragma unroll
          for (int i = 0; i < 2; ++i) { const int idx = tid + NTHREADS * i, t = idx >> 4, c0 = (idx & 15) * 8;
              u32x4 oa; oa[0] = pk2(sA[t * LST + c0], sA[t * LST + c0 + 1]); oa[1] = pk2(sA[t * LST + c0 + 2], sA[t * LST + c0 + 3]); oa[2] = pk2(sA[t * LST + c0 + 4], sA[t * LST + c0 + 5]); oa[3] = pk2(sA[t * LST + c0 + 6], sA[t * LST + c0 + 7]);
              *(u32x4*)(AC + (size_t)(row0 + t) * 1024 + nb * 128 + c0) = oa;
              if (dir == 1) { u32x4 oh; oh[0] = pk2(sH[t * LST + c0], sH[t * LST + c0 + 1]); oh[1] = pk2(sH[t * LST + c0 + 2], sH[t * LST + c0 + 3]); oh[2] = pk2(sH[t * LST + c0 + 4], sH[t * LST + c0 + 5]); oh[3] = pk2(sH[t * LST + c0 + 6], sH[t * LST + c0 + 7]);
                  *(u32x4*)(HL + (size_t)(row0 + t) * 1024 + nb * 128 + c0) = oh; } } }
        __syncthreads();
    }
}

__device__ __forceinline__ void phase_prep0(const Frame& F) {
    DSUB_DECL;
    DSUB_BEGIN(11);
    { u32x4 pv[4]; float pg[4];
      if (F.bid < NU_GLA) gla_vg_load(F, F.bid, pv, pg);
      GlaPar gp; gla_par_load(F, F.bid & 3, gp);
      for (int u = F.bid; u < NU_GLA; u += F.G) gla_prep_unit(F, u, (u + F.G < NU_GLA) ? u + F.G : -1, pv, pg, gp); }
    __syncthreads();
    DSUB_END(11);
    DSUB_BEGIN(12);
    { u32x4 tr[3]; const int u0 = (F.bid + F.G - NU_GLA % F.G) % F.G;
      if (u0 < NU_LRU) lru_tile_load(F, u0, tr);
      LruPar lp; lru_par_load(F, u0 & 7, lp);
      for (int u = u0; u < NU_LRU; u += F.G) lru_prep_unit(F, u, (u + F.G < NU_LRU) ? u + F.G : -1, tr, lp); }
    DSUB_END(12);
}

template <int NVT> struct Eng {
    static constexpr int VROWS = 16 * NVT, VPIECES = VROWS * 8, NPV = (VPIECES + NTHREADS - 1) / NTHREADS;
    static constexpr int OFF_S = 0, OFF_V = VROWS * 136 * 2, OFF_K = OFF_V + VROWS * 72 * 2, OFF_X = OFF_K + 128 * 72 * 2;
    static_assert(OFF_X + 2048 <= 147456 - 16, "LDS");
    __device__ static __forceinline__ void load_vk(u32x4 (&pfV)[NPV], u32x4 (&pfK)[2], const bf16_t* VT, const bf16_t* KE, int tid) {
#pragma unroll
        for (int i = 0; i < NPV; ++i) { const int idx = tid + NTHREADS * i; if (NPV * NTHREADS == VPIECES || idx < VPIECES) pfV[i] = *(const u32x4*)(VT + (size_t)idx * 8); }
#pragma unroll
        for (int i = 0; i < 2; ++i) pfK[i] = *(const u32x4*)(KE + (size_t)(tid + NTHREADS * i) * 8);
    }
    __device__ static __forceinline__ void stage_vk(const u32x4 (&pfV)[NPV], const u32x4 (&pfK)[2], bf16_t* sV, bf16_t* sKe, int tid) {
#pragma unroll
        for (int i = 0; i < NPV; ++i) { const int idx = tid + NTHREADS * i; if (NPV * NTHREADS == VPIECES || idx < VPIECES) *(LAS u32x4*)((LAS bf16_t*)sV + (idx >> 3) * 72 + (idx & 7) * 8) = pfV[i]; }
#pragma unroll
        for (int i = 0; i < 2; ++i) { const int idx = tid + NTHREADS * i; *(LAS u32x4*)((LAS bf16_t*)sKe + (idx >> 3) * 72 + (idx & 7) * 8) = pfK[i]; }
    }
    template <class DecT>
    __device__ static __forceinline__ void update(f32x4 (&acc)[NVT], const bf16_t* sV, const bf16_t* sKe, DecT dec, int w, int lane) {
        const bf16x8 a0 = frag_l(sKe, 72, 16 * w, 0, lane), a1 = frag_l(sKe, 72, 16 * w, 32, lane);
#pragma unroll
        for (int v0 = 0; v0 < NVT; v0 += 4) { bf16x8 bb[8];
#pragma unroll
            for (int k = 0; k < 4; ++k) if (v0 + k < NVT) { bb[2 * k] = frag_l(sV, 72, 16 * (v0 + k), 0, lane); bb[2 * k + 1] = frag_l(sV, 72, 16 * (v0 + k), 32, lane); }
            SCHED_BAR();
#pragma unroll
            for (int k = 0; k < 4; ++k) if (v0 + k < NVT) { acc[v0 + k] = acc[v0 + k] * dec; acc[v0 + k] = MFMA16(a0, bb[2 * k], acc[v0 + k]); }
#pragma unroll
            for (int k = 0; k < 4; ++k) if (v0 + k < NVT) acc[v0 + k] = MFMA16(a1, bb[2 * k + 1], acc[v0 + k]);
            SCHED_BAR(); }
    }
    __device__ static __forceinline__ void to_lds(const f32x4 (&acc)[NVT], bf16_t* sS, int w, int lane) {
#pragma unroll
        for (int vt = 0; vt < NVT; ++vt) { u32x2 pk; pk[0] = pk2(acc[vt][0], acc[vt][1]); pk[1] = pk2(acc[vt][2], acc[vt][3]);
            *(LAS u32x2*)((LAS bf16_t*)sS + (16 * vt + (lane & 15)) * 136 + 16 * w + 4 * (lane >> 4)) = pk; }
    }
    __device__ static __forceinline__ void gather(f32x4 (&acc)[NVT], const bf16_t* sS, int w, int lane) {
#pragma unroll
        for (int vt = 0; vt < NVT; ++vt) { const u32x2 pk = *(const LAS u32x2*)((const LAS bf16_t*)sS + (16 * vt + (lane & 15)) * 136 + 16 * w + 4 * (lane >> 4));
            acc[vt][0] = bf2f((bf16_t)(pk[0] & 0xffffu)); acc[vt][1] = bf2f((bf16_t)(pk[0] >> 16)); acc[vt][2] = bf2f((bf16_t)(pk[1] & 0xffffu)); acc[vt][3] = bf2f((bf16_t)(pk[1] >> 16)); }
    }
    __device__ static __forceinline__ void fill_state(bf16_t* sS, const bf16_t* SB, bool zero, int tid) {
        OPAQUE(tid);
        for (int idx = tid; idx < VROWS * 16; idx += NTHREADS) { const int v = idx >> 4, d0 = (idx & 15) * 8; u32x4 x = {0u, 0u, 0u, 0u}; if (!zero) x = *(const u32x4*)(SB + v * 128 + d0); *(LAS u32x4*)((LAS bf16_t*)sS + v * 136 + d0) = x; }
    }
    __device__ static __forceinline__ void fill_state_dma(bf16_t* sS, const bf16_t* SB, bool zero, int tid, int w, int lane) {
        if (zero) { for (int idx = tid; idx < VROWS * 16; idx += NTHREADS) { const u32x4 z = {0u, 0u, 0u, 0u}; *(LAS u32x4*)((LAS bf16_t*)sS + (idx >> 4) * 136 + (idx & 15) * 8) = z; } return; }
#ifdef CPU_EMU
        (void)w; (void)lane; for (int idx = tid; idx < VROWS * 16; idx += NTHREADS) { const int v = idx >> 4, d0 = (idx & 15) * 8; *(u32x4*)(sS + v * 136 + d0) = *(const u32x4*)(SB + v * 128 + d0); }
#else
        for (int r = w; r < VROWS; r += NTHREADS / 64)
            __builtin_amdgcn_global_load_lds((const unsigned*)(SB + (size_t)r * 128 + 2 * lane), (LAS unsigned*)((LAS bf16_t*)sS + r * 136), 4, 0, 0);
#endif
    }
    __device__ static __forceinline__ void load_state(f32x4 (&acc)[NVT], bf16_t* sS, const bf16_t* SB, bool zero, int tid, int w, int lane) {
        for (int idx = tid; idx < VROWS * 16; idx += NTHREADS) { const int v = idx >> 4, d0 = (idx & 15) * 8; u32x4 x = {0u, 0u, 0u, 0u}; if (!zero) x = *(const u32x4*)(SB + v * 128 + d0); *(LAS u32x4*)((LAS bf16_t*)sS + v * 136 + d0) = x; }
        __syncthreads();
#pragma unroll
        for (int vt = 0; vt < NVT; ++vt) { const u32x2 pk = *(const LAS u32x2*)((const LAS bf16_t*)sS + (16 * vt + (lane & 15)) * 136 + 16 * w + 4 * (lane >> 4));
            acc[vt][0] = bf2f((bf16_t)(pk[0] & 0xffffu)); acc[vt][1] = bf2f((bf16_t)(pk[0] >> 16)); acc[vt][2] = bf2f((bf16_t)(pk[1] & 0xffffu)); acc[vt][3] = bf2f((bf16_t)(pk[1] >> 16)); }
    }
    __device__ static __forceinline__ void store_state(const bf16_t* sS, bf16_t* KVG, int tid) {
        for (int idx = tid; idx < VROWS * 16; idx += NTHREADS) { const int v = idx >> 4, d0 = (idx & 15) * 8; *(u32x4*)(KVG + v * 128 + d0) = *(const LAS u32x4*)((const LAS bf16_t*)sS + v * 136 + d0); }
    }
};

__device__ __forceinline__ void phase_agg0(const Frame& F) {
    const int tid = F.tid, lane = F.lane, w = F.wave;
    { constexpr int RUN = (NCH + 7) / 8; float* sRA = (float*)F.lds; float* sRH = sRA + 8 * 64;
      const float* AT = PAP(float, PA0_AT); const float* HT = PAP(float, PA0_HT); float* HIN = PAP(float, PA0_HIN);
      for (int u = F.bid; u < 2 * BATCH * 16; u += F.G) { const int dir = u / (BATCH * 16), b = (u / 16) % BATCH, ch = (u % 16) * 64 + lane;
          const int i0 = w * RUN, i1 = (i0 + RUN < NCH) ? i0 + RUN : NCH;
          float A = 1.f, H = 0.f;
#pragma unroll 8
          for (int i = i0; i < i1; ++i) { const size_t ix = (((size_t)dir * BATCH + b) * NCH + scan_chunk(dir, i)) * 1024 + ch; const float a = AT[ix]; H = a * H + HT[ix]; A *= a; }
          sRA[w * 64 + lane] = A; sRH[w * 64 + lane] = H;
          __syncthreads();
          float st = 0.f;
          for (int w2 = 0; w2 < w; ++w2) st = sRA[w2 * 64 + lane] * st + sRH[w2 * 64 + lane];
#pragma unroll 8
          for (int i = i0; i < i1; ++i) { const size_t ix = (((size_t)dir * BATCH + b) * NCH + scan_chunk(dir, i)) * 1024 + ch; const float a = AT[ix], hh = HT[ix]; HIN[ix] = st; st = a * st + hh; }
          __syncthreads(); } }
    typedef Eng<16> E;
    bf16_t* sS = (bf16_t*)(F.lds + E::OFF_S); bf16_t* sV = (bf16_t*)(F.lds + E::OFF_V); bf16_t* sKe = (bf16_t*)(F.lds + E::OFF_K);
    constexpr int NUA = BATCH * NGRP * 8;
    u32x4 pfV[E::NPV], pfK[2]; f32x4 decn;
#define AGG0_LOAD(uu, jj) do { const int h_ = (uu) & 3, b_ = ((uu) >> 2) & 1, dir_ = ((uu) >> 3) & 1, g_ = (uu) >> 4; const int ug_ = (b_ * NCH + group_chunk(g_, dir_, (jj))) * 4 + h_; \
        E::load_vk(pfV, pfK, PAP(bf16_t, PA0_VT) + (size_t)ug_ * 256 * 64, PAP(bf16_t, PA0_KE) + ((size_t)ug_ * 2 + dir_) * 128 * 64, tid); \
        decn = *(const f32x4*)(PAP(float, PA0_DEC) + ((size_t)ug_ * 2 + dir_) * 128 + 16 * w + 4 * (lane >> 4)); } while (0)
    if (F.bid < NUA) AGG0_LOAD(F.bid, 0);
    for (int u = F.bid; u < NUA; u += F.G) {
        const int h = u & 3, b = (u >> 2) & 1, dir = (u >> 3) & 1, g = u >> 4, scan = (b * 4 + h) * 2 + dir;
        f32x4 acc[16];
#pragma unroll
        for (int vt = 0; vt < 16; ++vt) acc[vt] = fzero4();
        f32x4 decp = {1.f, 1.f, 1.f, 1.f};
        for (int j = 0; j < GC; ++j) {
            __syncthreads();
            E::stage_vk(pfV, pfK, sV, sKe, tid);
            const f32x4 dec = decn;
            __syncthreads();
            if (j + 1 < GC) AGG0_LOAD(u, j + 1); else if (u + F.G < NUA) AGG0_LOAD(u + F.G, 0);
            E::update(acc, sV, sKe, dec, w, lane);
            decp = decp * dec; }
        MFMA_DRAIN();
        E::to_lds(acc, sS, w, lane);
        if ((lane & 15) == 0) *(f32x4*)(PAP(float, PA0_DECG) + ((size_t)scan * NGRP + g) * 128 + 16 * w + 4 * (lane >> 4)) = decp;
        __syncthreads();
        E::store_state(sS, PAP(bf16_t, PA0_KVG) + ((size_t)scan * NGRP + g) * 32768, tid);
    }
#undef AGG0_LOAD
}

template <int NSCAN, int ELEMS, bool VEC>
__device__ __forceinline__ void group_scan(const Frame& F, bf16_t* KVG, const float* DECG) {
    constexpr int E4 = ELEMS / 4;
    for (int idx = F.bid * NTHREADS + F.tid; idx < NSCAN * E4; idx += F.G * NTHREADS) {
        const int scan = idx / E4, e4 = idx % E4, d0 = (e4 & 31) * 4, dir = scan & 1;
        bf16_t* base = KVG + (size_t)scan * NGRP * ELEMS + (size_t)e4 * 4; const float* dbase = DECG + (size_t)scan * NGRP * (VEC ? 128 : 1) + (VEC ? d0 : 0);
        float s4[4] = {0.f, 0.f, 0.f, 0.f};
        u32x2 kvb[8]; f32x4 dcb[8];
#pragma unroll
        for (int k = 0; k < 8; ++k) if (k < NGRP) { const int g = scan_group(dir, k); kvb[k] = *(const u32x2*)(base + (size_t)g * ELEMS);
            if (VEC) dcb[k] = *(const f32x4*)(dbase + (size_t)g * 128); else { const float x = dbase[g]; dcb[k] = (f32x4){x, x, x, x}; } }
        for (int i0 = 0; i0 < NGRP; i0 += 8) {
#pragma unroll
            for (int k = 0; k < 8; ++k) { const int i = i0 + k; if (i < NGRP) { const int g = scan_group(dir, i); const u32x2 kv = kvb[k]; const f32x4 dc = dcb[k];
                if (i + 8 < NGRP) { const int g2 = scan_group(dir, i + 8); kvb[k] = *(const u32x2*)(base + (size_t)g2 * ELEMS);
                    if (VEC) dcb[k] = *(const f32x4*)(dbase + (size_t)g2 * 128); else { const float x = dbase[g2]; dcb[k] = (f32x4){x, x, x, x}; } }
                u32x2 o; o[0] = pk2(s4[0], s4[1]); o[1] = pk2(s4[2], s4[3]); *(u32x2*)(base + (size_t)g * ELEMS) = o;
                s4[0] = dc[0] * s4[0] + bf2f((bf16_t)(kv[0] & 0xffffu)); s4[1] = dc[1] * s4[1] + bf2f((bf16_t)(kv[0] >> 16));
                s4[2] = dc[2] * s4[2] + bf2f((bf16_t)(kv[1] & 0xffffu)); s4[3] = dc[3] * s4[3] + bf2f((bf16_t)(kv[1] >> 16)); } }
        }
    }
}
__device__ __forceinline__ void phase_gscan0(const Frame& F) { group_scan<16, 32768, true>(F, PAP(bf16_t, PA0_KVG), PAP(float, PA0_DECG)); }

__device__ __forceinline__ void o_to_lds(const f32x4 (&o)[8], bf16_t* sO, int mt, int vh, int lane) {
    LAS bf16_t* p = (LAS bf16_t*)sO + (16 * mt + (lane & 15)) * 264 + 128 * vh + 4 * (lane >> 4);
#pragma unroll
    for (int i = 0; i < 8; ++i) { u32x2 pk; pk[0] = pk2(o[i][0], o[i][1]); pk[1] = pk2(o[i][2], o[i][3]); *(LAS u32x2*)(p + 16 * i) = pk; }
}
__device__ __forceinline__ float half_wave_sum(float v) { v += __shfl_xor(v, 16); v += __shfl_xor(v, 8); v += __shfl_xor(v, 4); v += __shfl_xor(v, 2); v += __shfl_xor(v, 1); return v; }
__device__ __forceinline__ void unpack8(const u32x4 x, float (&f)[8]) {
#pragma unroll
    for (int e = 0; e < 4; ++e) { f[2 * e] = bf2f((bf16_t)(x[e] & 0xffffu)); f[2 * e + 1] = bf2f((bf16_t)(x[e] >> 16)); }
}
__device__ __forceinline__ void gla_out_unit(const Frame& F, int u, int u_next, bool have_state) {
    typedef Eng<16> E;
    const int h = u & 3, bg = u >> 2, b = bg / NGRP, g = bg % NGRP;
    int tz0 = threadIdx.x; OPAQUE(tz0);
    const int tid = tz0, lane = tz0 & 63, w = RFL(tz0 >> 6), mt = w & 3, vh = w >> 2;
    bf16_t* sS = (bf16_t*)(F.lds + E::OFF_S); bf16_t* sV = (bf16_t*)(F.lds + E::OFF_V); bf16_t* sKe = (bf16_t*)(F.lds + E::OFF_K);
    bf16_t* sO = sV;
    const bf16_t* P = PAP(bf16_t, PA_P); bf16_t* Mix = WSP(bf16_t, WS_ACT);
#pragma unroll 1
    for (int dir = 0; dir < 2; ++dir) {
        const int scan = (b * 4 + h) * 2 + dir; const bool first = (g == scan_group(dir, 0));
        const bf16_t* QD = PAP(bf16_t, PA0_QD) + (size_t)dir * T * 512 + h * 128;
        u32x4 pfV[E::NPV], pfK[2]; bf16x8 aAtt[2], aQ[4]; f32x4 decn;
#define GLA_PTRS(jx) const int c_ = group_chunk(g, dir, (jx)), ug_ = (b * NCH + c_) * 4 + h, row0_ = chunk_row0(b, c_); \
        const bf16_t* VT_ = PAP(bf16_t, PA0_VT) + (size_t)ug_ * 256 * 64; const bf16_t* KE_ = PAP(bf16_t, PA0_KE) + ((size_t)ug_ * 2 + dir) * 128 * 64; \
        const bf16_t* ATT_ = PAP(bf16_t, PA0_ATT) + ((size_t)ug_ * 2 + dir) * 64 * 64;
#define GLA_LOAD_A() do { _Pragma("unroll") for (int ks = 0; ks < 2; ++ks) aAtt[ks] = frag(ATT_, 64, 16 * mt, 32 * ks, lane); \
        _Pragma("unroll") for (int ks = 0; ks < 4; ++ks) aQ[ks] = frag(QD + (size_t)row0_ * 512, 512, 16 * mt, 32 * ks, lane); \
        decn = *(const f32x4*)(PAP(float, PA0_DEC) + ((size_t)ug_ * 2 + dir) * 128 + 16 * w + 4 * (lane >> 4)); } while (0)
        { GLA_PTRS(0) E::load_vk(pfV, pfK, VT_, KE_, tid); (void)ATT_; (void)row0_; }
        if (dir == 0 && !have_state) { __syncthreads(); E::fill_state(sS, PAP(bf16_t, PA0_KVG) + ((size_t)scan * NGRP + g) * 32768, first, tid); }
        else {
#ifndef CPU_EMU
            asm volatile("s_waitcnt vmcnt(0)" ::: "memory");
#endif
        }
        const bf16_t* nSB = nullptr; bool nzero = false, nhave = false;
        if (dir == 0) { nSB = PAP(bf16_t, PA0_KVG) + ((size_t)(scan + 1) * NGRP + g) * 32768; nzero = (g == scan_group(1, 0)); nhave = true; }
        else if (u_next >= 0) { const int h2 = u_next & 3, bg2 = u_next >> 2, b2 = bg2 / NGRP, g2 = bg2 % NGRP; nSB = PAP(bf16_t, PA0_KVG) + ((size_t)((b2 * 4 + h2) * 2) * NGRP + g2) * 32768; nzero = (g2 == scan_group(0, 0)); nhave = true; }
#pragma unroll 1
        for (int j = 0; j < GC; ++j) {
            const int c = group_chunk(g, dir, j), row0 = chunk_row0(b, c);
            int tz = threadIdx.x; OPAQUE(tz);
            const int tid = tz, lane = tz & 63, w = RFL(tz >> 6), mt = w & 3, vh = w >> 2;
            { GLA_PTRS(j) (void)VT_; (void)KE_; GLA_LOAD_A(); }
            __syncthreads();
            E::stage_vk(pfV, pfK, sV, sKe, tid);
            bf16x8 cAtt[2], cQ[4];
#pragma unroll
            for (int ks = 0; ks < 2; ++ks) cAtt[ks] = aAtt[ks];
#pragma unroll
            for (int ks = 0; ks < 4; ++ks) cQ[ks] = aQ[ks];
            const f32x4 dec = decn;
            __syncthreads();
            u32x4 part[4], gate[4];
            if (dir == 1) {
#pragma unroll
                for (int i = 0; i < 4; ++i) { const int id = tid + NTHREADS * i, row = id >> 5, c8 = (id & 31) * 8;
                    part[i] = *(const u32x4*)(Mix + (size_t)(row0 + row) * DMIX + h * 256 + c8); gate[i] = *(const u32x4*)(P + (size_t)(row0 + row) * NP0 + 2048 + h * 256 + c8); } }
            f32x4 o[8];
#pragma unroll
            for (int i = 0; i < 8; ++i) o[i] = fzero4();
#pragma unroll
            for (int ks = 0; ks < 2; ++ks) { bf16x8 bb[8];
#pragma unroll
                for (int i = 0; i < 8; ++i) bb[i] = frag_l(sV, 72, 16 * (8 * vh + i), 32 * ks, lane);
                SCHED_BAR();
#pragma unroll
                for (int i = 0; i < 8; ++i) o[i] = MFMA16(bb[i], cAtt[ks], o[i]);
                SCHED_BAR(); }
#pragma unroll
            for (int ks = 0; ks < 4; ++ks) { bf16x8 bb[8];
#pragma unroll
                for (int i = 0; i < 8; ++i) bb[i] = frag_l(sS, 136, 16 * (8 * vh + i), 32 * ks, lane);
                SCHED_BAR();
#pragma unroll
                for (int i = 0; i < 8; ++i) o[i] = MFMA16(bb[i], cQ[ks], o[i]);
                SCHED_BAR(); }
            f32x4 acc[16];
            if (j + 1 < GC) { E::gather(acc, sS, w, lane); E::update(acc, sV, sKe, dec, w, lane); }
            __syncthreads();
            if (j + 1 < GC) E::to_lds(acc, sS, w, lane); else if (nhave) E::fill_state_dma(sS, nSB, nzero, tid, w, lane);
            o_to_lds(o, sO, mt, vh, lane);
            if (j + 1 < GC) { GLA_PTRS(j + 1) E::load_vk(pfV, pfK, VT_, KE_, tid); (void)ATT_; (void)row0_; }
            f32x4 nw0 = fzero4(), nw1 = fzero4();
            if (dir == 1) { nw0 = *(const f32x4*)(F.in[11] + (tid & 31) * 8); nw1 = *(const f32x4*)(F.in[11] + (tid & 31) * 8 + 4); }
            __syncthreads();
#pragma unroll
            for (int i = 0; i < 4; ++i) { const int id = tid + NTHREADS * i, row = id >> 5, c8 = (id & 31) * 8;
                const u32x4 ov = *(const LAS u32x4*)((const LAS bf16_t*)sO + row * 264 + c8);
                bf16_t* dst = Mix + (size_t)(row0 + row) * DMIX + h * 256 + c8;
                if (dir == 0) { *(u32x4*)dst = ov; }
                else { float x[8], p8[8], g8[8]; unpack8(ov, x); unpack8(part[i], p8); unpack8(gate[i], g8); float ss = 0.f;
#pragma unroll
                    for (int e = 0; e < 8; ++e) { x[e] += p8[e]; ss += x[e] * x[e]; }
                    const float rs = frsq(half_wave_sum(ss) * (1.f / 256.f) + LN_EPS);
                    const f32x4 n0 = nw0, n1 = nw1;
#pragma unroll
                    for (int e = 0; e < 8; ++e) x[e] = x[e] * rs * (e < 4 ? n0[e & 3] : n1[e & 3]) * siluf_(g8[e]);
                    u32x4 pk; pk[0] = pk2(x[0], x[1]); pk[1] = pk2(x[2], x[3]); pk[2] = pk2(x[4], x[5]); pk[3] = pk2(x[6], x[7]);
                    *(u32x4*)dst = pk; } }
        }
#undef GLA_PTRS
#undef GLA_LOAD_A
    }
}
__device__ __forceinline__ void phase_out0(const Frame& F) {
    constexpr int NUO = BATCH * NGRP * 4;
#if defined(TEST_GLA_ONLY)
    for (int u = F.bid; u < NUO; u += F.G) gla_out_unit(F, u);
#elif defined(TEST_LRU_ONLY)
    ;
#else
    { bool have = false; for (int u = F.bid; u < NUO; u += F.G) { const int un = (u + F.G < NUO) ? u + F.G : -1; gla_out_unit(F, u, un, have); have = un >= 0; } }
    __syncthreads();
    { const bf16_t* P = PAP(bf16_t, PA_P); bf16_t* Mix = WSP(bf16_t, WS_ACT);
      const bf16_t* HL = PAP(bf16_t, PA0_HL); const bf16_t* ACF = PAP(bf16_t, PA0_ACF); const bf16_t* ACB = PAP(bf16_t, PA0_ACB); const float* HIN = PAP(float, PA0_HIN);
      constexpr size_t NIT = (size_t)T * 128; const size_t step = (size_t)F.G * NTHREADS;
#pragma unroll 1
      for (size_t idx0 = (size_t)F.bid * NTHREADS + F.tid; idx0 < NIT; idx0 += 2 * step) {
          bf16x8 hl[2], af[2], ab[2], xg[2]; f32x4 hf0[2], hf1[2], hb0[2], hb1[2];
#pragma unroll
          for (int q = 0; q < 2; ++q) { const size_t idx = idx0 + q * step; if (idx < NIT) {
              const int row = (int)(idx >> 7), ch0 = (int)(idx & 127) * 8;
              int b, c; if (row < TL) { b = row / SEQ; c = NCH_C + (row % SEQ) / 64; } else { b = (row - TL) / CTX; c = ((row - TL) % CTX) / 64; }
              const size_t o = (size_t)row * 1024 + ch0;
              hl[q] = *(const bf16x8*)(HL + o); af[q] = *(const bf16x8*)(ACF + o); ab[q] = *(const bf16x8*)(ACB + o); xg[q] = *(const bf16x8*)(P + (size_t)row * NP0 + 4096 + ch0);
              const float* hf = HIN + (((size_t)0 * BATCH + b) * NCH + c) * 1024 + ch0; const float* hb = HIN + (((size_t)1 * BATCH + b) * NCH + c) * 1024 + ch0;
              hf0[q] = *(const f32x4*)hf; hf1[q] = *(const f32x4*)(hf + 4); hb0[q] = *(const f32x4*)hb; hb1[q] = *(const f32x4*)(hb + 4); } }
#pragma unroll
          for (int q = 0; q < 2; ++q) { const size_t idx = idx0 + q * step; if (idx < NIT) {
              const int row = (int)(idx >> 7), ch0 = (int)(idx & 127) * 8;
              float y[8];
#pragma unroll
              for (int e = 0; e < 8; ++e) { const float hh = bf2f((bf16_t)hl[q][e]) + bf2f((bf16_t)af[q][e]) * (e < 4 ? hf0[q][e & 3] : hf1[q][e & 3]) + bf2f((bf16_t)ab[q][e]) * (e < 4 ? hb0[q][e & 3] : hb1[q][e & 3]); y[e] = hh * gelu_tanhf_(bf2f((bf16_t)xg[q][e])); }
              u32x4 pk; pk[0] = pk2(y[0], y[1]); pk[1] = pk2(y[2], y[3]); pk[2] = pk2(y[4], y[5]); pk[3] = pk2(y[6], y[7]);
              *(u32x4*)(Mix + (size_t)row * DMIX + 1024 + ch0) = pk; } } } }
    __syncthreads();
    moe_weight_cvt(F, 0, (unsigned*)(F.ws + WS_CTL) + 16);
#endif
}

struct LnCfg { int l, which, nrows, porder, router; };
__device__ __forceinline__ void phase_ln(const Frame& F, const LnCfg cfg) {
    const int l = cfg.l, tid = F.tid, lane = F.lane, w = F.wave;
    const float* MODS = WSP(float, WS_MODS) + (size_t)l * 3 * 6 * D;
    const float* lng = F.in[6] + ((size_t)l * 2 + cfg.which) * D; const float* lnb = F.in[7] + ((size_t)l * 2 + cfg.which) * D;
    bf16_t* ACT = WSP(bf16_t, WS_ACT);
    bf16_t* sU2 = (bf16_t*)F.lds;
    float* sPart = (float*)(F.lds + 16 * (D + 8) * 2);
    float* sLog = sPart + 8 * 16 * 48;
    int* sCnt = (int*)(F.lds + 131072);
    if (tid < 32) sCnt[tid] = 0;
    __syncthreads();
    const int NG = cfg.nrows / 16, g0 = (int)((long)F.bid * NG / F.G), g1 = (int)((long)(F.bid + 1) * NG / F.G);
    const bf16_t* Ymix = PAP(bf16_t, PA_YMIX); const bf16_t* Y = PAP(bf16_t, PA_Y); const int* TOKSLOT = WSP(int, WS_TOKSLOT);
    const float* MODS_N = WSP(float, WS_MODS) + (size_t)3 * 6 * D;
    constexpr int NV = D / 256;
    DSUB_DECL;
    float* sPar = (float*)F.lds;
    { const bool has_mod = (cfg.which == 0) || (l == 0);
      for (int i = tid; i < 11 * (D / 4); i += NTHREADS) { const int rowi = i / (D / 4), c4 = (i % (D / 4)) * 4; const float* src;
          if (rowi == 0) src = lng; else if (rowi == 1) src = lnb;
          else { const int mr_ = (rowi - 2) / 3, k_ = (rowi - 2) % 3;
              if (k_ == 0) src = MODS + (size_t)mr_ * 6 * D + (cfg.which ? 5 : 2) * D;
              else if (cfg.which == 0) src = MODS + (size_t)mr_ * 6 * D + (2 + k_) * D;
              else src = MODS_N + (size_t)mr_ * 6 * D + (k_ - 1) * D;
              if (k_ != 0 && !has_mod) continue; }
          *(f32x4*)(sPar + (size_t)rowi * D + c4) = *(const f32x4*)(src + c4); } }
    __syncthreads();
    f32x4 rxf[NV]; bf16x4 rxh[NV], rya[NV], ryb[NV]; float rtg[2] = {0.f, 0.f};
    int sl[2] = {0, 0}; float tg[2] = {0.f, 0.f};
#define LN_ROW(it) (16 * (g0 + ((it) >> 1)) + 2 * w + ((it) & 1))
#define LN_SLOTS(it) do { if (cfg.which) { const int row_ = LN_ROW(it); \
        sl[0] = TOKSLOT[2 * row_]; sl[1] = TOKSLOT[2 * row_ + 1]; tg[0] = WSP(float, WS_TOKG)[2 * row_]; tg[1] = WSP(float, WS_TOKG)[2 * row_ + 1]; } } while (0)
#define LN_ISSUE(it) do { const int row_ = LN_ROW(it); const float* xin_; \
        if (row_ < TL) { const int xrow_ = cfg.porder ? raster_of_p(row_) : row_; xin_ = (l == 0 && cfg.which == 0) ? F.in[0] + (size_t)xrow_ * D : F.out + (size_t)xrow_ * D; } \
        else xin_ = F.in[2] + (size_t)(row_ - TL) * D; \
        rtg[0] = tg[0]; rtg[1] = tg[1]; \
        _Pragma("unroll") for (int i = 0; i < NV; ++i) { const int col = i * 256 + lane * 4; \
            if (cfg.which == 0) { if (l == 0) rxf[i] = *(const f32x4*)(xin_ + col); else rxh[i] = *(const bf16x4*)((const bf16_t*)xin_ + col); rya[i] = *(const bf16x4*)(Ymix + (size_t)row_ * D + col); } \
            else { rxh[i] = *(const bf16x4*)(PAP(bf16_t, PA_XB) + (size_t)row_ * D + col); rya[i] = *(const bf16x4*)(Y + (size_t)sl[0] * D + col); ryb[i] = *(const bf16x4*)(Y + (size_t)sl[1] * D + col); } } } while (0)
    const int nit = 2 * (g1 - g0);
    if (nit > 0) { LN_SLOTS(0); LN_ISSUE(0); LN_SLOTS(1); }
#pragma unroll 1
    for (int it = 0; it < nit; ++it) {
        const int row = LN_ROW(it);
        const int mr = row < TL ? row / SEQ : 2;
        const float* sMG = sPar + (size_t)(2 + 3 * mr) * D;
        float z[NV][4]; float s1 = 0.f;
#pragma unroll
        for (int i = 0; i < NV; ++i) { const int col = i * 256 + lane * 4; const f32x4 gt = *(const f32x4*)(sMG + col);
            float x[4], y[4];
            if (cfg.which == 0) {
#pragma unroll
                for (int e = 0; e < 4; ++e) { x[e] = (l == 0) ? rxf[i][e] : bf2f((bf16_t)rxh[i][e]); y[e] = bf2f((bf16_t)rya[i][e]); } }
            else {
#pragma unroll
                for (int e = 0; e < 4; ++e) { x[e] = bf2f((bf16_t)rxh[i][e]); y[e] = rtg[0] * bf2f((bf16_t)rya[i][e]) + rtg[1] * bf2f((bf16_t)ryb[i][e]); } }
#pragma unroll
            for (int e = 0; e < 4; ++e) { z[i][e] = ALPHA * x[e] + gt[e] * y[e]; s1 += z[i][e]; } }
        if (it + 1 < nit) { LN_ISSUE(it + 1); if (it + 2 < nit) LN_SLOTS(it + 2); }
#pragma unroll
        for (int m = 32; m >= 1; m >>= 1) s1 += __shfl_xor(s1, m);
        const float mu = s1 * (1.f / D);
        float s2 = 0.f;
#pragma unroll
        for (int i = 0; i < NV; ++i)
#pragma unroll
            for (int e = 0; e < 4; ++e) { const float dlt = z[i][e] - mu; s2 += dlt * dlt; }
#pragma unroll
        for (int m = 32; m >= 1; m >>= 1) s2 += __shfl_xor(s2, m);
        const float rstd = 1.f / sqrtf(s2 * (1.f / D) + LN_EPS);
        float* xout_ = nullptr; bf16_t* actp;
        if (cfg.which == 0) actp = ACT + (size_t)row * D;
        else { if (row < TL) { const int xrow = cfg.porder ? raster_of_p(row) : row; xout_ = F.out + (size_t)xrow * D; }
            int urow = row; if (row < TL) { const int bq = row / SEQ, s_ = row % SEQ, r_ = s_ / GRIDW, w_ = s_ % GRIDW; urow = bq * SEQ + w_ * GROWS + r_; }
            actp = ACT + (size_t)urow * D; }
#pragma unroll
        for (int i = 0; i < NV; ++i) { const int col = i * 256 + lane * 4; const f32x4 gg = *(const f32x4*)(sPar + col), bb = *(const f32x4*)(sPar + D + col);
            f32x4 sh = {0.f, 0.f, 0.f, 0.f}, sc = {0.f, 0.f, 0.f, 0.f};
            if (cfg.which == 0 || l == 0) { sh = *(const f32x4*)(sMG + D + col); sc = *(const f32x4*)(sMG + 2 * D + col); }
            f32x4 xo;
#pragma unroll
            for (int e = 0; e < 4; ++e) xo[e] = (z[i][e] - mu) * rstd * gg[e] + bb[e];
            if (cfg.which == 0) { u32x2 px; px[0] = pk2(xo[0], xo[1]); px[1] = pk2(xo[2], xo[3]); *(u32x2*)(PAP(bf16_t, PA_XB) + (size_t)row * D + col) = px; }
            else if (l == 1) *(f32x4*)(xout_ + col) = xo;
            else if (xout_) { u32x2 px; px[0] = pk2(xo[0], xo[1]); px[1] = pk2(xo[2], xo[3]); *(u32x2*)((bf16_t*)xout_ + col) = px; }
            if (cfg.which == 0 || l == 0) { u32x2 pk; pk[0] = pk2(xo[0] * (1.f + sc[0]) + sh[0], xo[1] * (1.f + sc[1]) + sh[1]); pk[1] = pk2(xo[2] * (1.f + sc[2]) + sh[2], xo[3] * (1.f + sc[3]) + sh[3]);
                *(u32x2*)(actp + col) = pk; } }
    }
#undef LN_ROW
#undef LN_SLOTS
#undef LN_ISSUE
    if (cfg.router) {
#ifndef CPU_EMU
        asm volatile("s_waitcnt vmcnt(0)" ::: "memory");
#endif
        __syncthreads();
        constexpr int KW = D / 8, NKS = KW / 32;
        const bf16_t* WR = WSP(bf16_t, WS_WR) + (size_t)l * 48 * D;
        bf16x8 bw[3][NKS];
#pragma unroll
        for (int nt_ = 0; nt_ < 3; ++nt_)
#pragma unroll
            for (int ks = 0; ks < NKS; ++ks) bw[nt_][ks] = frag(WR, D, 16 * nt_, w * KW + 32 * ks, lane);
        float* sPt = (float*)F.lds;
        float* sLg = sPt + 8 * 3 * 16 * 48;
        const int nmt = g1 - g0;
        for (int m0 = 0; m0 < nmt; m0 += 3) {
            const int nm = (nmt - m0) < 3 ? (nmt - m0) : 3;
            for (int mi = 0; mi < nm; ++mi) { const int rowb = 16 * (g0 + m0 + mi);
                bf16x8 a[NKS];
#pragma unroll
                for (int ks = 0; ks < NKS; ++ks) a[ks] = frag(ACT + (size_t)rowb * D, D, 0, w * KW + 32 * ks, lane);
                f32x4 acc[3] = {fzero4(), fzero4(), fzero4()};
#pragma unroll
                for (int ks = 0; ks < NKS; ++ks)
#pragma unroll
                    for (int nt_ = 0; nt_ < 3; ++nt_) acc[nt_] = MFMA16(a[ks], bw[nt_][ks], acc[nt_]);
#pragma unroll
                for (int nt_ = 0; nt_ < 3; ++nt_)
#pragma unroll
                    for (int j = 0; j < 4; ++j) sPt[((w * 3 + mi) * 16 + 4 * (lane >> 4) + j) * 48 + 16 * nt_ + (lane & 15)] = acc[nt_][j]; }
            __syncthreads();
            for (int i = tid; i < nm * 16 * 48; i += NTHREADS) { const int col = i % 48; float sm = 0.f;
#pragma unroll
                for (int q = 0; q < 8; ++q) sm += sPt[q * 3 * 16 * 48 + i];
                if (col < 4) sm += F.in[25][l * 4 + col]; else if (col < 36) sm += F.in[27][l * 32 + col - 4];
                sLg[i] = sm; }
            __syncthreads();
            if (tid < nm * 16) { const float* lg = sLg + tid * 48; const int row = 16 * (g0 + m0) + tid;
                int gi = 0; float gm = lg[0];
#pragma unroll
                for (int q = 1; q < 4; ++q) if (lg[q] > gm) { gm = lg[q]; gi = q; }
                float gs = 0.f;
#pragma unroll
                for (int q = 0; q < 4; ++q) gs += fexp(lg[q] - gm);
                const float pg = 1.f / gs;
                const float* el = lg + 4 + gi * 8;
                int i0 = 0; float mx0 = el[0];
#pragma unroll
                for (int q = 1; q < 8; ++q) if (el[q] > mx0) { mx0 = el[q]; i0 = q; }
                int i1 = -1; float mx1 = -3.0e38f;
#pragma unroll
                for (int q = 0; q < 8; ++q) if (q != i0 && el[q] > mx1) { mx1 = el[q]; i1 = q; }
                const float p1 = fexp(mx1 - mx0);
                const float g0_ = pg / (1.f + p1), g1_ = pg * p1 / (1.f + p1);
                const int e0 = gi * 8 + i0, e1 = gi * 8 + i1;
                WSP(int, WS_TOKE)[2 * row] = e0; WSP(int, WS_TOKE)[2 * row + 1] = e1; WSP(float, WS_TOKG)[2 * row] = g0_; WSP(float, WS_TOKG)[2 * row + 1] = g1_;
                atomicAdd(&sCnt[e0], 1); atomicAdd(&sCnt[e1], 1); }
            __syncthreads();
        }
        if (tid < 32) WSP(int, WS_WGCNT)[((size_t)l * 1024 + F.bid) * 32 + tid] = sCnt[tid];
    }
}

__device__ __forceinline__ void phase_slots(const Frame& F, int l, int nrows) {
    int* sTot = (int*)F.lds; int* sBefore = sTot + 32; int* sStart = sTot + 64; int* sCur = sTot + 96;
    const int tid = F.tid; const int* WGCNT = WSP(int, WS_WGCNT) + (size_t)l * 1024 * 32;
    { int* sPT = sTot + 128; int* sPB = sPT + 512;
      const int e = tid & 31, part = tid >> 5; int tot = 0, bef = 0;
#pragma unroll 4
      for (int wg = part; wg < F.G; wg += 16) { const int c = WGCNT[wg * 32 + e]; if (wg < F.bid) bef += c; tot += c; }
      sPT[tid] = tot; sPB[tid] = bef; }
    __syncthreads();
    if (tid < 32) { int tot = 0, bef = 0;
#pragma unroll
        for (int q = 0; q < 16; ++q) { tot += sTot[128 + q * 32 + tid]; bef += sTot[640 + q * 32 + tid]; }
        sTot[tid] = tot; sBefore[tid] = bef; sCur[tid] = 0; }
    __syncthreads();
    if (tid == 0) { int start = 0, tile = 0; int* TE = WSP(int, WS_TILEE);
        for (int e = 0; e < NEXP; ++e) { sStart[e] = start; const int nte = (sTot[e] + 255) / 256; if (F.bid == 0) for (int i = 0; i < nte; ++i) TE[64 + tile + i] = e; tile += nte; start += nte * 256; }
        if (F.bid == 0) TE[0] = tile; }
    __syncthreads();
    int* SLOT_TOK = WSP(int, WS_SLOTTOK); float* SLOT_GATE = WSP(float, WS_SLOTGATE); int* TOKSLOT = WSP(int, WS_TOKSLOT);
    for (int e = F.bid; e < NEXP; e += F.G) { const int lo = sStart[e] + sTot[e], hi = sStart[e] + ((sTot[e] + 255) / 256) * 256; for (int s = lo + tid; s < hi; s += NTHREADS) { SLOT_TOK[s] = 0; SLOT_GATE[s] = 0.f; } }
    const int NG = nrows / 16, r0 = 16 * (int)((long)F.bid * NG / F.G), r1 = 16 * (int)((long)(F.bid + 1) * NG / F.G);
    const int* TOKE = WSP(int, WS_TOKE); const float* TOKG = WSP(float, WS_TOKG);
    for (int idx = tid; idx < (r1 - r0) * 2; idx += NTHREADS) { const int row = r0 + (idx >> 1), k = idx & 1; const int e = TOKE[2 * row + k]; const int pos = atomicAdd(&sCur[e], 1);
        const int slot = sStart[e] + sBefore[e] + pos; SLOT_TOK[slot] = row; SLOT_GATE[slot] = TOKG[2 * row + k]; TOKSLOT[2 * row + k] = slot; }
}

struct MlIn { u32x4 q[2], k[2], v[4]; float g; };
__device__ __forceinline__ void ml_in_load(const Frame& F, int um, MlIn& in) {
    const int h = um & 7, bc = um >> 3, b = bc / NCH, c = bc % NCH, row0 = chunk_row0(b, c);
    const bf16_t* P = PAP(bf16_t, PA_P); const float* Gt = WSP(float, WS_G); const int tid = threadIdx.x;
#pragma unroll
    for (int i = 0; i < 2; ++i) { const int idx = tid + NTHREADS * i, t = idx >> 4, d0 = (idx & 15) * 8;
        in.q[i] = *(const u32x4*)(P + (size_t)(row0 + t) * NP1 + h * 128 + d0); in.k[i] = *(const u32x4*)(P + (size_t)(row0 + t) * NP1 + 1024 + h * 128 + d0); }
#pragma unroll
    for (int i = 0; i < 4; ++i) { const int idx = tid + NTHREADS * i, s_ = idx >> 5, vc = idx & 31; in.v[i] = *(const u32x4*)(P + (size_t)(row0 + s_) * NP1 + 2048 + h * 256 + vc * 8); }
    if (tid < 256) { const int t = tid >> 2, q = tid & 3; in.g = Gt[(size_t)(row0 + t) * 32 + q * 8 + h] + F.in[21][q * 8 + h]; }
    else { const int idx = tid - 256, dir = idx >> 7, t = (idx >> 1) & 63, which = idx & 1; const int pos = scan_chunk(dir, c);
        float v = 0.f; if (pos > 0) { const int rp = chunk_row0(b, scan_chunk(dir, pos - 1)); v = Gt[(size_t)(rp + t) * 32 + (2 * dir + which) * 8 + h] + F.in[21][(2 * dir + which) * 8 + h]; }
        in.g = v; }
}
__device__ __forceinline__ void ml_prep_unit(const Frame& F, int um, int um_next, MlIn& in) {
    const int h = um & 7, bc = um >> 3, b = bc / NCH, c = bc % NCH, row0 = chunk_row0(b, c);
    bf16_t* sQ = (bf16_t*)(F.lds + 0);
    bf16_t* sK = (bf16_t*)(F.lds + 17408);
    bf16_t* sV = (bf16_t*)(F.lds + 34816);
    float* sGt = (float*)(F.lds + 68608);
    float* sGpv = (float*)(F.lds + 69632);
    float* sB = (float*)(F.lds + 70656);
    float* sAa = sB + 128;
    float* sPm = sAa + 128;
    float* sSc = sPm + 128;
    float* sKw = sSc + 4;
    const int tid = F.tid, lane = F.lane, w = F.wave;
#pragma unroll
    for (int i = 0; i < 2; ++i) { const int idx = tid + NTHREADS * i, t = idx >> 4, d0 = (idx & 15) * 8; *(u32x4*)(sQ + t * 136 + d0) = in.q[i]; *(u32x4*)(sK + t * 136 + (((idx & 15) ^ ((t >> 3) & 7)) * 8)) = in.k[i]; }
#pragma unroll
    for (int i = 0; i < 4; ++i) { const int idx = tid + NTHREADS * i, s_ = idx >> 5, vc = idx & 31; *(u32x4*)(sV + s_ * 264 + ((vc ^ ((s_ >> 3) & 7)) * 8)) = in.v[i]; }
    if (tid < 256) sGt[tid] = in.g; else sGpv[tid - 256] = in.g;
    if (um_next >= 0) ml_in_load(F, um_next, in);
    __syncthreads();
    f32x4 qk[2];
    { const int mt = w & 3, nt0 = (w >> 2) * 2;
#pragma unroll
      for (int nn = 0; nn < 2; ++nn) { f32x4 acc = fzero4();
#pragma unroll
          for (int ks = 0; ks < 4; ++ks) { const int krow = 16 * (nt0 + nn) + (lane & 15), kpc = (4 * ks + (lane >> 4)) ^ ((krow >> 3) & 7);
              acc = MFMA16(*(const LAS bf16x8*)((const LAS bf16_t*)sK + krow * 136 + kpc * 8), frag_l(sQ, 136, 16 * mt, 32 * ks, lane), acc); }
          qk[nn] = acc; } }
    if (w < 4) { const int dir = w & 1, prev = w >> 1, t = dir ? 63 - lane : lane;
        const float ig = prev ? sGpv[(dir * 64 + t) * 2] : sGt[t * 4 + 2 * dir], fl = log_sigmoidf_(prev ? sGpv[(dir * 64 + t) * 2 + 1] : sGt[t * 4 + 2 * dir + 1]);
        float run = fl;
#pragma unroll
        for (int k = 1; k < 64; k <<= 1) { const float o = __shfl(run, lane - k); if (lane >= k) run += o; }
        const float a = ig - run; float pm = a;
#pragma unroll
        for (int k = 1; k < 64; k <<= 1) { const float o = __shfl(pm, lane - k); if (lane >= k) pm = fmaxf(pm, o); }
        const float pall = __shfl(pm, 63);
        if (!prev) { sB[dir * 64 + t] = run; sAa[dir * 64 + t] = a; sPm[dir * 64 + t] = pm; sKw[dir * 64 + t] = fexp(a - pall); if (lane == 63) sSc[2 + dir] = pm; }
        else if (lane == 63) sSc[dir] = (scan_chunk(dir, c) > 0) ? run + pm : -1.0e30f; }
    __syncthreads();
#pragma unroll
    for (int dir = 0; dir < 2; ++dir) { const float mu = sSc[dir], Pall = sSc[2 + dir];
        { const int mt = w & 3, nt0 = (w >> 2) * 2; bf16_t* SM = PAP(bf16_t, PA1_SM) + ((size_t)um * 2 + dir) * 4096;
          const int t = 16 * mt + (lane & 15); const float Mt = fmaxf(mu, sPm[dir * 64 + t]);
#pragma unroll
          for (int nn = 0; nn < 2; ++nn) { const int s0 = 16 * (nt0 + nn) + 4 * (lane >> 4); float m4[4];
#pragma unroll
              for (int j = 0; j < 4; ++j) { const int s_ = s0 + j; const bool keep = dir == 0 ? (s_ <= t) : (s_ >= t); m4[j] = keep ? qk[nn][j] * fexp(sAa[dir * 64 + s_] - Mt) : 0.f; }
              u32x2 pk; pk[0] = pk2(m4[0], m4[1]); pk[1] = pk2(m4[2], m4[3]); *(u32x2*)(SM + t * 64 + s0) = pk; } }
        if (tid < 64) { const float Mt = fmaxf(mu, sPm[dir * 64 + tid]); float* WF = PAP(float, PA1_WF) + ((size_t)um * 2 + dir) * 128; WF[tid] = fexp(mu - Mt); WF[64 + tid] = fexp(-(sB[dir * 64 + tid] + Mt)); }
        if (tid == 64) PAP(float, PA1_DEC)[(size_t)um * 2 + dir] = fexp(mu - Pall);
        { bf16_t* KEW = PAP(bf16_t, PA1_KEW) + ((size_t)um * 2 + dir) * 128 * 64;
#pragma unroll
          for (int i = 0; i < 2; ++i) { const int idx = tid + NTHREADS * i, d = idx >> 3, sc = idx & 7; float x[8];
#pragma unroll
              for (int e = 0; e < 8; ++e) x[e] = bf2f(sK[(sc * 8 + e) * 136 + ((((d >> 3) ^ sc) << 3) | (d & 7))]) * sKw[dir * 64 + sc * 8 + e];
              u32x4 pk; pk[0] = pk2(x[0], x[1]); pk[1] = pk2(x[2], x[3]); pk[2] = pk2(x[4], x[5]); pk[3] = pk2(x[6], x[7]);
              *(u32x4*)(KEW + d * 64 + sc * 8) = pk; } } }
    { bf16_t* VT = PAP(bf16_t, PA1_VT) + (size_t)um * MLV * 64;
#pragma unroll
      for (int i = 0; i < 4; ++i) { const int idx = tid + NTHREADS * i, v = idx >> 3, sc = idx & 7; bf16x8 o;
#pragma unroll
          for (int e = 0; e < 8; ++e) o[e] = (short)sV[(sc * 8 + e) * 264 + ((((v >> 3) ^ sc) << 3) | (v & 7))];
          *(bf16x8*)(VT + v * 64 + sc * 8) = o; }
      if (tid < 128) { const unsigned one2 = (tid >> 3) == 0 ? 0x3F803F80u : 0u; u32x4 o = {one2, one2, one2, one2}; *(u32x4*)(VT + (256 + (tid >> 3)) * 64 + (tid & 7) * 8) = o; } }
    __syncthreads();
}
__device__ __forceinline__ void phase_prep1(const Frame& F) { MlIn in; if (F.bid < NU_ML) ml_in_load(F, F.bid, in); for (int u = F.bid; u < NU_ML; u += F.G) ml_prep_unit(F, u, (u + F.G < NU_ML) ? u + F.G : -1, in); }

__device__ __forceinline__ void phase_agg1(const Frame& F) {
    typedef Eng<17> E;
    const int tid = F.tid, lane = F.lane, w = F.wave;
    bf16_t* sS = (bf16_t*)(F.lds + E::OFF_S); bf16_t* sV = (bf16_t*)(F.lds + E::OFF_V); bf16_t* sKe = (bf16_t*)(F.lds + E::OFF_K);
    constexpr int NUA = BATCH * NGRP * 16;
    u32x4 pfV[E::NPV], pfK[2]; float decn;
#define AGG1_LOAD(uu, jj) do { const int h_ = (uu) & 7, dir_ = ((uu) >> 3) & 1, bg_ = (uu) >> 4, b_ = bg_ / NGRP, g_ = bg_ % NGRP; const int um_ = (b_ * NCH + group_chunk(g_, dir_, (jj))) * 8 + h_; \
        E::load_vk(pfV, pfK, PAP(bf16_t, PA1_VT) + (size_t)um_ * MLV * 64, PAP(bf16_t, PA1_KEW) + ((size_t)um_ * 2 + dir_) * 128 * 64, tid); decn = PAP(float, PA1_DEC)[(size_t)um_ * 2 + dir_]; } while (0)
    if (F.bid < NUA) AGG1_LOAD(F.bid, 0);
    for (int u = F.bid; u < NUA; u += F.G) {
        const int h = u & 7, dir = (u >> 3) & 1, bg = u >> 4, b = bg / NGRP, g = bg % NGRP, scan = (b * 8 + h) * 2 + dir;
        f32x4 acc[17];
#pragma unroll
        for (int vt = 0; vt < 17; ++vt) acc[vt] = fzero4();
        float Dg = 1.f;
        for (int j = 0; j < GC; ++j) {
            __syncthreads();
            E::stage_vk(pfV, pfK, sV, sKe, tid);
            const float dec = decn;
            __syncthreads();
            if (j + 1 < GC) AGG1_LOAD(u, j + 1); else if (u + F.G < NUA) AGG1_LOAD(u + F.G, 0);
            E::update(acc, sV, sKe, dec, w, lane);
            Dg *= dec; }
        MFMA_DRAIN();
        E::to_lds(acc, sS, w, lane);
        if (tid == 0) PAP(float, PA1_DG)[(size_t)scan * NGRP + g] = Dg;
        __syncthreads();
        E::store_state(sS, PAP(bf16_t, PA1_KVG) + ((size_t)scan * NGRP + g) * (MLV * 128), tid);
    }
#undef AGG1_LOAD
}
__device__ __forceinline__ void phase_gscan1(const Frame& F) { group_scan<32, MLV * 128, false>(F, PAP(bf16_t, PA1_KVG), PAP(float, PA1_DG)); }

__device__ __forceinline__ void ml_out_unit(const Frame& F, int u, int u_next, bool have_state) {
    typedef Eng<17> E;
    const int h = u & 7, bg = u >> 3, b = bg / NGL, g = NGC + bg % NGL;
    int tz0 = threadIdx.x; OPAQUE(tz0);
    const int tid = tz0, lane = tz0 & 63, w = RFL(tz0 >> 6), mt = w & 3, vh = w >> 2;
    bf16_t* sS = (bf16_t*)(F.lds + E::OFF_S); bf16_t* sV = (bf16_t*)(F.lds + E::OFF_V); bf16_t* sKe = (bf16_t*)(F.lds + E::OFF_K);
    bf16_t* sO = sV;
    float* sDen = (float*)(F.lds + E::OFF_X);
    const bf16_t* P = PAP(bf16_t, PA_P); bf16_t* Mix = WSP(bf16_t, WS_ACT);
    const int tq = 16 * mt + 4 * (lane >> 4); (void)tq;
    DSUB_DECL;
    DSUB_BEGIN(7);
#pragma unroll 1
    for (int dir = 0; dir < 2; ++dir) {
        const int scan = (b * 8 + h) * 2 + dir; const bool first = (g == scan_group(dir, 0));
        DSUB_BEGIN(1);
        u32x4 pfV[E::NPV], pfK[2]; bf16x8 aSm[2], aQ[4]; float win, fln, decn;
#define ML_PTRS(jx) const int c_ = group_chunk(g, dir, (jx)), um_ = (b * NCH + c_) * 8 + h, row0_ = chunk_row0(b, c_); \
        const bf16_t* VT_ = PAP(bf16_t, PA1_VT) + (size_t)um_ * MLV * 64; const bf16_t* KE_ = PAP(bf16_t, PA1_KEW) + ((size_t)um_ * 2 + dir) * 128 * 64;
#define ML_LOAD_A() do { const bf16_t* SM_ = PAP(bf16_t, PA1_SM) + ((size_t)um_ * 2 + dir) * 4096; \
        _Pragma("unroll") for (int ks = 0; ks < 2; ++ks) aSm[ks] = frag(SM_, 64, 16 * mt, 32 * ks, lane); \
        _Pragma("unroll") for (int ks = 0; ks < 4; ++ks) aQ[ks] = frag(P + (size_t)row0_ * NP1 + h * 128, NP1, 16 * mt, 32 * ks, lane); \
        win = PAP(float, PA1_WF)[((size_t)um_ * 2 + dir) * 128 + 16 * mt + (lane & 15)]; fln = PAP(float, PA1_WF)[((size_t)um_ * 2 + dir) * 128 + 64 + 16 * mt + (lane & 15)]; decn = PAP(float, PA1_DEC)[(size_t)um_ * 2 + dir]; } while (0)
        { ML_PTRS(0) E::load_vk(pfV, pfK, VT_, KE_, tid); (void)row0_; }
        if (dir == 0 && !have_state) { __syncthreads(); E::fill_state(sS, PAP(bf16_t, PA1_KVG) + ((size_t)scan * NGRP + g) * (MLV * 128), first, tid); }
        else {
#ifndef CPU_EMU
            asm volatile("s_waitcnt vmcnt(0)" ::: "memory");
#endif
        }
        const bf16_t* nSB = nullptr; bool nzero = false, nhave = false;
        if (dir == 0) { nSB = PAP(bf16_t, PA1_KVG) + ((size_t)(scan + 1) * NGRP + g) * (MLV * 128); nzero = (g == scan_group(1, 0)); nhave = true; }
        else if (u_next >= 0) { const int h2 = u_next & 7, bg2 = u_next >> 3, b2 = bg2 / NGL, g2 = NGC + bg2 % NGL; nSB = PAP(bf16_t, PA1_KVG) + ((size_t)((b2 * 8 + h2) * 2) * NGRP + g2) * (MLV * 128); nzero = (g2 == scan_group(0, 0)); nhave = true; }
        DSUB_END(1);
#pragma unroll 1
        for (int j = 0; j < GC; ++j) {
            const int c = group_chunk(g, dir, j), row0 = chunk_row0(b, c);
            int tz = threadIdx.x; OPAQUE(tz);
            const int tid = tz, lane = tz & 63, w = RFL(tz >> 6), mt = w & 3, vh = w >> 2, tq = 16 * mt + 4 * (lane >> 4);
            DSUB_BEGIN(2);
            { ML_PTRS(j) (void)VT_; (void)KE_; ML_LOAD_A(); }
            __syncthreads();
            E::stage_vk(pfV, pfK, sV, sKe, tid);
            bf16x8 cSm[2], cQ[4];
#pragma unroll
            for (int ks = 0; ks < 2; ++ks) cSm[ks] = aSm[ks];
#pragma unroll
            for (int ks = 0; ks < 4; ++ks) cQ[ks] = aQ[ks];
            const float dec = decn, wi = win, fl = fln;
            __syncthreads();
            DSUB_END(2);
            DSUB_BEGIN(3);
            f32x4 o[8], od = fzero4();
#pragma unroll
            for (int i = 0; i < 8; ++i) o[i] = fzero4();
#pragma unroll
            for (int ks = 0; ks < 4; ++ks) {
#pragma unroll
                for (int hb = 0; hb < 2; ++hb) { bf16x8 bb[4], bd;
#pragma unroll
                    for (int i = 0; i < 4; ++i) bb[i] = frag_l(sS, 136, 16 * (8 * vh + 4 * hb + i), 32 * ks, lane);
                    if (vh == 1 && hb == 1) bd = frag_l(sS, 136, 256, 32 * ks, lane);
                    SCHED_BAR();
#pragma unroll
                    for (int i = 0; i < 4; ++i) o[4 * hb + i] = MFMA16(bb[i], cQ[ks], o[4 * hb + i]);
                    if (vh == 1 && hb == 1) od = MFMA16(bd, cQ[ks], od);
                    SCHED_BAR(); } }
            od = od * wi;
#pragma unroll
            for (int i = 0; i < 8; ++i) o[i] = o[i] * wi;
#pragma unroll
            for (int ks = 0; ks < 2; ++ks) {
#pragma unroll
                for (int hb = 0; hb < 2; ++hb) { bf16x8 bb[4], bd;
#pragma unroll
                    for (int i = 0; i < 4; ++i) bb[i] = frag_l(sV, 72, 16 * (8 * vh + 4 * hb + i), 32 * ks, lane);
                    if (vh == 1 && hb == 1) bd = frag_l(sV, 72, 256, 32 * ks, lane);
                    SCHED_BAR();
#pragma unroll
                    for (int i = 0; i < 4; ++i) o[4 * hb + i] = MFMA16(bb[i], cSm[ks], o[4 * hb + i]);
                    if (vh == 1 && hb == 1) od = MFMA16(bd, cSm[ks], od);
                    SCHED_BAR(); } }
            DSUB_END(3);
            DSUB_BEGIN(4);
            f32x4 acc[17];
            if (j + 1 < GC) { E::gather(acc, sS, w, lane); E::update(acc, sV, sKe, dec, w, lane); }
            DSUB_END(4);
            DSUB_BEGIN(5);
            __syncthreads();
            if (j + 1 < GC) E::to_lds(acc, sS, w, lane);
            o_to_lds(o, sO, mt, vh, lane);
            if (j + 1 < GC) { ML_PTRS(j + 1) E::load_vk(pfV, pfK, VT_, KE_, tid); (void)row0_; }
            u32x4 part[4], gate[4]; f32x4 nw0 = fzero4(), nw1 = fzero4();
            if (dir == 1) { nw0 = *(const f32x4*)(F.in[22] + (tid & 31) * 8); nw1 = *(const f32x4*)(F.in[22] + (tid & 31) * 8 + 4);
#pragma unroll
                for (int i = 0; i < 4; ++i) { const int id = tid + NTHREADS * i, row = id >> 5, c8 = (id & 31) * 8;
                    part[i] = *(const u32x4*)(Mix + (size_t)(row0 + row) * DMIX + h * 256 + c8); gate[i] = *(const u32x4*)(P + (size_t)(row0 + row) * NP1 + 4096 + h * 256 + c8); } }
            if (vh == 1 && lane < 16) ((LAS float*)sDen)[16 * mt + lane] = 1.f / fmaxf(fabsf(od[0]), fl);
            if (j + 1 == GC && nhave) E::fill_state_dma(sS, nSB, nzero, tid, w, lane);
            __syncthreads();
            DSUB_END(5);
            DSUB_BEGIN(6);
#pragma unroll
            for (int i = 0; i < 4; ++i) { const int id = tid + NTHREADS * i, row = id >> 5, c8 = (id & 31) * 8;
                const u32x4 ov = *(const LAS u32x4*)((const LAS bf16_t*)sO + row * 264 + c8);
                const float inv = ((const LAS float*)sDen)[row];
                bf16_t* dst = Mix + (size_t)(row0 + row) * DMIX + h * 256 + c8;
                float x[8]; unpack8(ov, x);
#pragma unroll
                for (int e = 0; e < 8; ++e) x[e] *= inv;
                if (dir == 1) { float p8[8], g8[8]; unpack8(part[i], p8); unpack8(gate[i], g8); float ss = 0.f;
#pragma unroll
                    for (int e = 0; e < 8; ++e) { x[e] += p8[e]; ss += x[e] * x[e]; }
                    const float rs = frsq(half_wave_sum(ss) * (1.f / 256.f) + LN_EPS);
                    const f32x4 n0 = nw0, n1 = nw1;
#pragma unroll
                    for (int e = 0; e < 8; ++e) x[e] = x[e] * rs * (e < 4 ? n0[e & 3] : n1[e & 3]) * sigmoidf_(g8[e]); }
                u32x4 pk; pk[0] = pk2(x[0], x[1]); pk[1] = pk2(x[2], x[3]); pk[2] = pk2(x[4], x[5]); pk[3] = pk2(x[6], x[7]);
                *(u32x4*)dst = pk; }
            DSUB_END(6);
        }
#undef ML_PTRS
#undef ML_LOAD_A
    }
    DSUB_END(7);
}
__device__ __forceinline__ void phase_out1(const Frame& F) { bool have = false; for (int u = F.bid; u < BATCH * NGL * 8; u += F.G) { const int un = (u + F.G < BATCH * NGL * 8) ? u + F.G : -1; ml_out_unit(F, u, un, have); have = un >= 0; } }

constexpr int N_PHASES = 24;
constexpr int LDS_BYTES = 147456;
#ifdef CPU_EMU
#define GRID_BAR() do { } while (0)
#else
#define GRID_BAR() xcd_barrier(bar)
#endif

__global__ void __launch_bounds__(NTHREADS, 2) mk_fwd(Args args) {
#ifdef CPU_EMU
    unsigned char* lds = emu_blk->lds;
#else
    extern __shared__ __attribute__((aligned(16))) unsigned char lds_raw[];
    unsigned char* lds = (unsigned char*)lds_raw;
#endif
    Frame F; F.in = args.in; F.out = args.out; F.ws = args.ws; F.lds = lds;
    F.tid = threadIdx.x; F.lane = F.tid & 63; F.wave = RFL(F.tid >> 6); F.G = gridDim.x; F.bid = blockIdx.x;
#ifndef CPU_EMU
    LAS unsigned char* ldsl = (LAS unsigned char*)lds_raw;
    volatile LAS unsigned* bst = (volatile LAS unsigned*)(ldsl + LDS_BYTES - 16);
    if (F.tid == 0) { bst[0] = 0u; bst[1] = 0u; }
    __syncthreads();
    XcdBarrier bar = xcd_barrier_post((unsigned*)(args.ws + WS_CTL) + 1024, bst);
#endif
    const int lo = args.ph_lo, hi = args.ph_hi;
#if defined(DIAG_SUB) && !defined(CPU_EMU)
    if (F.tid == 0) *(volatile LAS unsigned long long*)(ldsl + LDS_BYTES - 32) = 0ull;
#endif
#ifdef ONLY_PH
#define IN(k) ((k) == ONLY_PH && lo <= (k) && (k) < hi)
#else
#define IN(k) (lo <= (k) && (k) < hi)
#endif
#define SEAM(k) do { if (IN(k) && IN((k) + 1)) GRID_BAR(); } while (0)
#ifdef CPU_EMU
#define GEMM_LDS lds
#else
#define GEMM_LDS ldsl
#endif
#ifdef DIAG_MASK
    unsigned long long dg_t0 = 0, dg_acc = 0;
#define DIAG0(k) do { if ((DIAG_MASK >> (k)) & 1) dg_t0 = wall_clock64(); } while (0)
#define DIAG1(k) do { if ((DIAG_MASK >> (k)) & 1) dg_acc += wall_clock64() - dg_t0; } while (0)
#else
#define DIAG0(k) do { } while (0)
#define DIAG1(k) do { } while (0)
#endif
    DIAG0(0); if (IN(0)) { phase_prologue(F); } SEAM(0); DIAG1(0);
    DIAG0(1); if (IN(1)) { phase_modulate0(F); } SEAM(1); DIAG1(1);
    DIAG0(2); if (IN(2)) { Gemm g{WSP(bf16_t, WS_ACT), WSP(bf16_t, WS_WIN0), D, nullptr}; StaticOrder S{T / 256, NW0 / 256, F.G, F.bid}; EpiIn E{PAP(bf16_t, PA_P), NP0, WSP(float, WS_G), NP0 / 256};
        gemm_phase(GEMM_LDS, g, S, E); } SEAM(2); DIAG1(2);
    DIAG0(3); if (IN(3)) { phase_prep0(F); } SEAM(3); DIAG1(3);
    DIAG0(4); if (IN(4)) { phase_agg0(F); } SEAM(4); DIAG1(4);
    DIAG0(5); if (IN(5)) { phase_gscan0(F); } SEAM(5); DIAG1(5);
    DIAG0(6); if (IN(6)) { phase_out0(F); } SEAM(6); DIAG1(6);
    DIAG0(7); if (IN(7)) { Gemm g{WSP(bf16_t, WS_ACT), WSP(bf16_t, WS_WOUT0), DMIX, nullptr}; StaticOrder S{TL / 256, D / 256, F.G, F.bid}; EpiBf E{PAP(bf16_t, PA_YMIX), D};
        gemm_phase(GEMM_LDS, g, S, E);
        ctx_outproj(F, WSP(bf16_t, WS_ACT), WSP(bf16_t, WS_WOUT0), PAP(bf16_t, PA_YMIX)); } SEAM(7); DIAG1(7);
    DIAG0(8); if (IN(8)) { phase_ln(F, LnCfg{0, 0, T, 0, 1}); } SEAM(8); DIAG1(8);
    DIAG0(9); if (IN(9)) { phase_slots(F, 0, T); } SEAM(9); DIAG1(9);
    DIAG0(10); if (IN(10)) { const int* TE = WSP(int, WS_TILEE); Gemm g{WSP(bf16_t, WS_ACT), WSP(bf16_t, WS_MOEW1), D, WSP(int, WS_SLOTTOK)}; MoeOrder S{TE + 64, TE[0], 4, F.G, F.bid}; EpiMoe1 E{PAP(bf16_t, PA_H)};
        gemm_phase(GEMM_LDS, g, S, E); } SEAM(10); DIAG1(10);
    DIAG0(11); if (IN(11)) { const int* TE = WSP(int, WS_TILEE); Gemm g{PAP(bf16_t, PA_H), WSP(bf16_t, WS_MOEW2), DEXP, nullptr}; MoeOrder S{TE + 64, TE[0], D / 256, F.G, F.bid}; EpiMoe2 E{PAP(bf16_t, PA_Y), WSP(float, WS_SLOTGATE), D / 256};
        gemm_phase(GEMM_LDS, g, S, E); } SEAM(11); DIAG1(11);
    DIAG0(12); if (IN(12)) { phase_ln(F, LnCfg{0, 1, T, 0, 0}); } SEAM(12); DIAG1(12);
    DIAG0(13); if (IN(13)) { Gemm g{WSP(bf16_t, WS_ACT), WSP(bf16_t, WS_WIN1), D, nullptr}; StaticOrder S{T / 256, NW1 / 256, F.G, F.bid}; EpiIn E{PAP(bf16_t, PA_P), NP1, WSP(float, WS_G), NP1 / 256};
        const bool cvt_first = ((F.bid >> 3) & 1) == 0;
        if (cvt_first) { moe_weight_cvt(F, 1); __syncthreads(); }
        gemm_phase(GEMM_LDS, g, S, E);
        if (!cvt_first) { __syncthreads(); moe_weight_cvt(F, 1); } } SEAM(13); DIAG1(13);
    DIAG0(14); if (IN(14)) { phase_prep1(F); } SEAM(14); DIAG1(14);
    DIAG0(15); if (IN(15)) { phase_agg1(F); } SEAM(15); DIAG1(15);
    DIAG0(16); if (IN(16)) { phase_gscan1(F); } SEAM(16); DIAG1(16);
    DIAG0(17); if (IN(17)) { phase_out1(F); } SEAM(17); DIAG1(17);
    DIAG0(18); if (IN(18)) { Gemm g{WSP(bf16_t, WS_ACT), WSP(bf16_t, WS_WOUT1), DMIX, nullptr}; StaticOrder S{TL / 256, D / 256, F.G, F.bid}; EpiBf E{PAP(bf16_t, PA_YMIX), D};
        gemm_phase(GEMM_LDS, g, S, E); } SEAM(18); DIAG1(18);
    DIAG0(19); if (IN(19)) { phase_ln(F, LnCfg{1, 0, TL, 1, 1}); } SEAM(19); DIAG1(19);
    DIAG0(20); if (IN(20)) { phase_slots(F, 1, TL); } SEAM(20); DIAG1(20);
    DIAG0(21); if (IN(21)) { const int* TE = WSP(int, WS_TILEE); Gemm g{WSP(bf16_t, WS_ACT), WSP(bf16_t, WS_MOEW1), D, WSP(int, WS_SLOTTOK)}; MoeOrder S{TE + 64, TE[0], 4, F.G, F.bid}; EpiMoe1 E{PAP(bf16_t, PA_H)};
        gemm_phase(GEMM_LDS, g, S, E); } SEAM(21); DIAG1(21);
    DIAG0(22); if (IN(22)) { const int* TE = WSP(int, WS_TILEE); Gemm g{PAP(bf16_t, PA_H), WSP(bf16_t, WS_MOEW2), DEXP, nullptr}; MoeOrder S{TE + 64, TE[0], D / 256, F.G, F.bid}; EpiMoe2 E{PAP(bf16_t, PA_Y), WSP(float, WS_SLOTGATE), D / 256};
        gemm_phase(GEMM_LDS, g, S, E); } SEAM(22); DIAG1(22);
    DIAG0(23); if (IN(23)) { phase_ln(F, LnCfg{1, 1, TL, 1, 0}); } DIAG1(23);
#if defined(DIAG_SUB) && !defined(CPU_EMU)
    if (blockIdx.x == 0 && F.tid == 0) { const unsigned long long te = wall_clock64(), want = *(volatile LAS unsigned long long*)(ldsl + LDS_BYTES - 32) * DIAG_MULT; while (wall_clock64() - te < want) __builtin_amdgcn_s_sleep(8); }
#endif
#ifdef DIAG_MASK
    if (blockIdx.x == 0) { const unsigned long long te = wall_clock64(), want = dg_acc * DIAG_MULT; while (wall_clock64() - te < want) __builtin_amdgcn_s_sleep(8); }
#endif
#undef IN
#undef SEAM
}

#ifndef MK_N_LAUNCHES
#define MK_N_LAUNCHES 1
#endif
extern "C" void kernel_launch(void* const* d_in, const int* in_sizes, int n_in, void* d_out, int out_size, void* d_ws, size_t ws_size, hipStream_t stream) {
    (void)in_sizes; (void)out_size;
    Args a{};
    for (int i = 0; i < 31 && i < n_in; ++i) a.in[i] = (const float*)d_in[i];
    a.out = (float*)d_out; a.ws = (unsigned char*)d_ws;
#ifdef CPU_EMU
    if (ws_size < WS_END) { fprintf(stderr, "ws too small: %zu < %zu\n", ws_size, (size_t)WS_END); return; }
    int grid = 32; const char* eg = getenv("EMU_GRID"); if (eg) grid = atoi(eg);
    int p0 = 0, p1 = N_PHASES; const char* e0 = getenv("EMU_PH0"); if (e0) p0 = atoi(e0); const char* e1 = getenv("EMU_PH1"); if (e1) p1 = atoi(e1);
    for (int ph = p0; ph < p1; ++ph) { a.ph_lo = ph; a.ph_hi = ph + 1; fprintf(stderr, "[emu] phase %d\n", ph); emu_launch(mk_fwd, grid, NTHREADS, LDS_BYTES, a); }
#else
    static int grid = 0;
    if (grid == 0) {
        if (n_in != 31 || ws_size < WS_END) { fprintf(stderr, "kernel_launch: n_in %d ws %zu (need %zu)\n", n_in, ws_size, (size_t)WS_END); grid = -1; return; }
        int dev = 0, cus = 0, per_cu = 0;
        hipGetDevice(&dev); hipDeviceGetAttribute(&cus, hipDeviceAttributeMultiprocessorCount, dev);
        if (hipFuncSetAttribute((const void*)mk_fwd, hipFuncAttributeMaxDynamicSharedMemorySize, LDS_BYTES) != hipSuccess) { fprintf(stderr, "kernel_launch: hipFuncSetAttribute failed\n"); grid = -1; return; }
        if (hipOccupancyMaxActiveBlocksPerMultiprocessor(&per_cu, (const void*)mk_fwd, NTHREADS, LDS_BYTES) != hipSuccess || per_cu < 1) { fprintf(stderr, "kernel_launch: occupancy query says %d\n", per_cu); }
        (void)hipGetLastError();
        grid = cus - cus % 8;
    }
    if (grid < 0) return;
    hipMemsetAsync((char*)d_ws + WS_CTL, 0, CTL_BYTES, stream);
    constexpr int NL = MK_N_LAUNCHES;
    for (int li = 0; li < NL; ++li) {
        a.ph_lo = (int)((long)li * N_PHASES / NL); a.ph_hi = (int)((long)(li + 1) * N_PHASES / NL);
        hipLaunchKernelGGL(mk_fwd, dim3(grid), dim3(NTHREADS), LDS_BYTES, stream, a);
    }
#endif
}
```
